# Optimizing an MI355X kernel written in HIP

```python
import math
import jax, jax.numpy as jnp
from jax import lax
import numpy as np


D_MODEL = 1024
BATCH = 8
SEQ = 4096
DEPTH = 1

MIX_WIDTH = D_MODEL
NSA_WIDTH = MIX_WIDTH // 2
NSA_HEAD_DIM = 64
NSA_HEADS = NSA_WIDTH // NSA_HEAD_DIM
NSA_KV_HEADS = 2
NSA_GROUP = NSA_HEADS // NSA_KV_HEADS
NSA_KV_WIDTH = NSA_KV_HEADS * NSA_HEAD_DIM
CMP_STRIDE = 16
CMP_BLOCK = 2 * CMP_STRIDE
CMP_HIDDEN = 4 * NSA_HEAD_DIM
SEL_BLOCK = 64
N_SELECT = 16
WINDOW = 512
Q_BLOCK = 128
FORCED_SCORE = 1.0e4
MLSTM_WIDTH = MIX_WIDTH - NSA_WIDTH
MLSTM_HEADS = 4
MLSTM_V_DIM = MLSTM_WIDTH // MLSTM_HEADS
MLSTM_QK_DIM = MLSTM_V_DIM // 2
MLSTM_QK_WIDTH = MLSTM_HEADS * MLSTM_QK_DIM
MLSTM_CHUNK = 64
CONV_WIDTH = 4
REL_BUCKETS = 32
REL_MAX_DISTANCE = 128
MEM_TOKENS = 256
XATTN_HEADS = 4
XATTN_HEAD_DIM = D_MODEL // XATTN_HEADS
D_FF = -(-8 * D_MODEL // (3 * 256)) * 256
NORM_EPS = 1e-6
NEG_INF = -1.0e30

IN_SIZES = (NSA_WIDTH,) + (NSA_KV_WIDTH,) * 6 + (NSA_HEADS * 3, MLSTM_QK_WIDTH, MLSTM_QK_WIDTH,
            MLSTM_WIDTH, MLSTM_HEADS, MLSTM_HEADS, MLSTM_WIDTH)
IN_WIDTH = sum(IN_SIZES)
IN_OFFSETS = tuple(int(o) for o in np.cumsum(IN_SIZES)[:-1])

kernel_name = 'hymba_nsa_mlstm_hybrid_layer'


def rms_norm(x, gain):
    xf = x.astype(jnp.float32)
    y = xf * lax.rsqrt(jnp.mean(xf * xf, axis=-1, keepdims=True) + NORM_EPS)
    return (y * gain.astype(jnp.float32)).astype(x.dtype)


def rel_bucket(dist):
    n = jnp.maximum(dist, 0)
    max_exact = REL_BUCKETS // 2
    nf = jnp.maximum(n, 1).astype(jnp.float32)
    large = max_exact + (jnp.log(nf / max_exact) / math.log(REL_MAX_DISTANCE / max_exact)
                         * (REL_BUCKETS - max_exact)).astype(jnp.int32)
    large = jnp.minimum(large, REL_BUCKETS - 1)
    return jnp.where(n < max_exact, n, large)


def masked_softmax(s, mask):
    s = jnp.where(mask, s.astype(jnp.float32), NEG_INF)
    return jnp.where(mask, jax.nn.softmax(s, axis=-1), 0.0)


def compress_blocks(kv, pos, w1, w2):
    B, H, S, DH = kv.shape
    c = kv.reshape(B, H, S // CMP_STRIDE, CMP_STRIDE, DH)
    blocks = jnp.concatenate([c[:, :, :-1], c[:, :, 1:]], axis=3) + pos
    hid = jax.nn.silu(blocks.reshape(B, H, -1, CMP_BLOCK * DH) @ w1)
    return hid @ w2


def native_sparse_attention(q, k_cmp, v_cmp, k_slc, v_slc, k_win, v_win, gates, rel_bias):
    B, HKV, G, S, DH = q.shape
    n_cmp = k_cmp.shape[2]
    n_sel = S // SEL_BLOCK
    n_top = min(N_SELECT, n_sel)
    n_kwin = Q_BLOCK + WINDOW
    cmp_start = jnp.arange(n_cmp) * CMP_STRIDE
    cmp_end = cmp_start + (CMP_BLOCK - 1)
    sel_start = jnp.arange(n_sel) * SEL_BLOCK
    overlap = ((cmp_start[:, None] <= sel_start[None, :] + SEL_BLOCK - 1)
               & (cmp_end[:, None] >= sel_start[None, :])).astype(jnp.float32)
    k_blk = k_slc.reshape(B, HKV, n_sel, SEL_BLOCK, DH)
    v_blk = v_slc.reshape(B, HKV, n_sel, SEL_BLOCK, DH)
    k_pad = jnp.pad(k_win, ((0, 0), (0, 0), (WINDOW, 0), (0, 0)))
    v_pad = jnp.pad(v_win, ((0, 0), (0, 0), (WINDOW, 0), (0, 0)))
    gather = jax.vmap(jax.vmap(lambda blocks, idx: blocks[idx]))
    head_off = (jnp.arange(NSA_HEADS) * REL_BUCKETS).reshape(HKV, G)
    bias_flat = rel_bias.reshape(-1)
    blk_ids = jnp.arange(n_sel)

    def head_bias(dist):
        return rel_bias[:, rel_bucket(dist)].reshape(HKV, G, *dist.shape)

    def query_block(c):
        t0 = c * Q_BLOCK
        tq = t0 + jnp.arange(Q_BLOCK)
        qc = lax.dynamic_slice_in_dim(q, t0, Q_BLOCK, axis=3)
        gc = lax.dynamic_slice_in_dim(gates, t0, Q_BLOCK, axis=3)
        d_c = tq[:, None] - cmp_end[None, :]
        s_c = jnp.einsum('bhgtd,bhcd->bhgtc', qc, k_cmp).astype(jnp.float32) + head_bias(d_c)
        p_c = masked_softmax(s_c, d_c >= 0)
        o_c = jnp.einsum('bhgtc,bhcd->bhgtd', p_c.astype(v_cmp.dtype), v_cmp)
        imp = jnp.einsum('bhgtc,cj->bhtj', p_c, overlap)
        cur = tq // SEL_BLOCK
        forced = ((blk_ids[None, :] == 0) | (blk_ids[None, :] == cur[:, None])
                  | (blk_ids[None, :] == cur[:, None] - 1))
        score = jnp.where(forced, FORCED_SCORE, jnp.where(blk_ids[None, :] <= cur[:, None], imp, -1.0))
        _, idx = lax.top_k(score, n_top)
        k_s = gather(k_blk, idx).reshape(B, HKV, Q_BLOCK, n_top * SEL_BLOCK, DH)
        v_s = gather(v_blk, idx).reshape(B, HKV, Q_BLOCK, n_top * SEL_BLOCK, DH)
        kpos = (idx[..., None] * SEL_BLOCK + jnp.arange(SEL_BLOCK)).reshape(B, HKV, Q_BLOCK, n_top * SEL_BLOCK)
        d_s = tq[:, None] - kpos
        b_s = bias_flat[head_off[None, :, :, None, None] + rel_bucket(d_s)[:, :, None]]
        s_s = jnp.einsum('bhgtd,bhtkd->bhgtk', qc, k_s).astype(jnp.float32) + b_s
        p_s = masked_softmax(s_s, (d_s >= 0)[:, :, None])
        o_s = jnp.einsum('bhgtk,bhtkd->bhgtd', p_s.astype(v_s.dtype), v_s)
        k_w = lax.dynamic_slice_in_dim(k_pad, t0, n_kwin, axis=2)
        v_w = lax.dynamic_slice_in_dim(v_pad, t0, n_kwin, axis=2)
        kpos_w = t0 - WINDOW + jnp.arange(n_kwin)
        d_w = tq[:, None] - kpos_w[None, :]
        m_w = (d_w >= 0) & (d_w < WINDOW) & (kpos_w[None, :] >= 0)
        s_w = jnp.einsum('bhgtd,bhkd->bhgtk', qc, k_w).astype(jnp.float32) + head_bias(d_w)
        p_w = masked_softmax(s_w, m_w)
        o_w = jnp.einsum('bhgtk,bhkd->bhgtd', p_w.astype(v_w.dtype), v_w)
        return gc[..., 0:1] * o_c + gc[..., 1:2] * o_s + gc[..., 2:3] * o_w

    return lax.map(query_block, jnp.arange(S // Q_BLOCK))


def causal_depthwise_conv(u, w, b):
    y = lax.conv_general_dilated(u, w[:, None, :].astype(u.dtype), window_strides=(1,),
                                 padding=((CONV_WIDTH - 1, 0),), dimension_numbers=('NWC', 'WIO', 'NWC'),
                                 feature_group_count=u.shape[-1])
    return y + b


def mlstm_chunkwise(q, k, v, i_pre, log_f):
    B, S, H, DK = q.shape
    DV = v.shape[-1]
    L = MLSTM_CHUNK
    nc = S // L
    f32 = jnp.float32

    def chunks(t):
        return t.astype(f32).reshape(B, nc, L, H, -1).transpose(1, 0, 3, 2, 4)

    qs, ks, vs = chunks(q), chunks(k) * (DK ** -0.5), chunks(v)
    ig = chunks(i_pre[..., None])[..., 0]
    lf = chunks(log_f[..., None])[..., 0]
    causal = jnp.tril(jnp.ones((L, L), dtype=bool))

    def step(carry, inp):
        C, n, m = carry
        qc, kc, vc, ic, fc = inp
        b = jnp.cumsum(fc, axis=-1)
        D = jnp.where(causal, b[..., :, None] - b[..., None, :] + ic[..., None, :], NEG_INF)
        m_inter = b + m[..., None]
        m_t = jnp.maximum(m_inter, jnp.max(D, axis=-1))
        w = jnp.exp(D - m_t[..., None])
        a = jnp.exp(m_inter - m_t)
        s = jnp.einsum('bhtd,bhsd->bhts', qc, kc) * w
        num = jnp.einsum('bhts,bhsv->bhtv', s, vc) + a[..., None] * jnp.einsum('bhtd,bhdv->bhtv', qc, C)
        den = jnp.sum(s, axis=-1) + a * jnp.einsum('bhtd,bhd->bht', qc, n)
        h = num / jnp.maximum(jnp.abs(den), jnp.exp(-m_t))[..., None]
        bL = b[..., -1]
        ws = bL[..., None] - b + ic
        m_next = jnp.maximum(bL + m, jnp.max(ws, axis=-1))
        decay = jnp.exp(bL + m - m_next)
        kw = kc * jnp.exp(ws - m_next[..., None])[..., None]
        C = decay[..., None, None] * C + jnp.einsum('bhsd,bhsv->bhdv', kw, vc)
        n = decay[..., None] * n + jnp.sum(kw, axis=2)
        return (C, n, m_next), h

    init = (jnp.zeros((B, H, DK, DV), f32), jnp.zeros((B, H, DK), f32), jnp.zeros((B, H), f32))
    _, hs = lax.scan(step, init, (qs, ks, vs, ig, lf))
    return hs.transpose(1, 0, 3, 2, 4).reshape(B, S, H, DV)


def hybrid_mixer(h, rel_bias, w_in, cmp_pos_k, cmp_pos_v, cmp_w1_k, cmp_w2_k, cmp_w1_v, cmp_w2_v,
                 conv_w, conv_b, mlstm_gate_bias, mlstm_norm, w_out):
    B, S, _ = h.shape
    (nq, kc, vc, ksl, vsl, kwn, vwn, gt, mq, mk, mv, mi, mf, mo) = jnp.split(h @ w_in, IN_OFFSETS, axis=-1)

    def kv_heads(t):
        return t.reshape(B, S, NSA_KV_HEADS, NSA_HEAD_DIM).transpose(0, 2, 1, 3)

    q = nq.reshape(B, S, NSA_KV_HEADS, NSA_GROUP, NSA_HEAD_DIM).transpose(0, 2, 3, 1, 4) * (NSA_HEAD_DIM ** -0.5)
    k_cmp = compress_blocks(kv_heads(kc), cmp_pos_k, cmp_w1_k, cmp_w2_k)
    v_cmp = compress_blocks(kv_heads(vc), cmp_pos_v, cmp_w1_v, cmp_w2_v)
    gates = jax.nn.sigmoid(gt.reshape(B, S, NSA_KV_HEADS, NSA_GROUP, 3).transpose(0, 2, 3, 1, 4))
    o = native_sparse_attention(q, k_cmp, v_cmp, kv_heads(ksl), kv_heads(vsl), kv_heads(kwn), kv_heads(vwn),
                                gates, rel_bias)
    y_nsa = o.transpose(1, 0, 4, 2, 3, 5).reshape(B, S, NSA_WIDTH)

    qk = jax.nn.silu(causal_depthwise_conv(jnp.concatenate([mq, mk], axis=-1), conv_w, conv_b))
    mq, mk = jnp.split(qk, 2, axis=-1)
    hm = mlstm_chunkwise(mq.reshape(B, S, MLSTM_HEADS, MLSTM_QK_DIM), mk.reshape(B, S, MLSTM_HEADS, MLSTM_QK_DIM),
                         mv.reshape(B, S, MLSTM_HEADS, MLSTM_V_DIM),
                         mi.astype(jnp.float32) + mlstm_gate_bias[0].astype(jnp.float32),
                         jax.nn.log_sigmoid(mf.astype(jnp.float32) + mlstm_gate_bias[1].astype(jnp.float32)))
    hm = hm * lax.rsqrt(jnp.mean(hm * hm, axis=-1, keepdims=True) + NORM_EPS)
    hm = (hm.reshape(B, S, MLSTM_WIDTH) * mlstm_norm.astype(jnp.float32)).astype(h.dtype)
    y_ml = jax.nn.sigmoid(mo) * hm

    return jnp.concatenate([y_nsa, y_ml], axis=-1) @ w_out


def memory_cross_attention(h, mem_n, w_xq, w_xkv, w_xo):
    B, S, _ = h.shape
    M = mem_n.shape[1]
    q = (h @ w_xq).reshape(B, S, XATTN_HEADS, XATTN_HEAD_DIM) * (XATTN_HEAD_DIM ** -0.5)
    k, v = jnp.split(mem_n @ w_xkv, 2, axis=-1)
    k = k.reshape(B, M, XATTN_HEADS, XATTN_HEAD_DIM)
    v = v.reshape(B, M, XATTN_HEADS, XATTN_HEAD_DIM)
    p = jax.nn.softmax(jnp.einsum('bshd,bmhd->bhsm', q, k).astype(jnp.float32), axis=-1)
    o = jnp.einsum('bhsm,bmhd->bshd', p.astype(v.dtype), v).reshape(B, S, D_MODEL)
    return o @ w_xo


def swiglu_ffn(h, w_gate_up, w_down):
    g, u = jnp.split(h @ w_gate_up, 2, axis=-1)
    return (jax.nn.silu(g) * u) @ w_down


def setup_inputs(seed: int = 0) -> dict:
    key = jax.random.key(seed)
    keys = iter(jax.random.split(key, 40))

    def nrm(shape, scale):
        return scale * jax.random.normal(next(keys), shape, jnp.float32)

    def gain(width=D_MODEL):
        return 1.0 + nrm((DEPTH, width), 0.02)

    inputs = {}
    inputs['x'] = nrm((BATCH, SEQ, D_MODEL), 1.0)
    inputs['mem'] = nrm((BATCH, MEM_TOKENS, D_MODEL), 1.0)
    inputs['rel_bias'] = nrm((NSA_HEADS, REL_BUCKETS), 0.5)
    inputs['mix_norm_pre'] = gain()
    inputs['w_in'] = nrm((DEPTH, D_MODEL, IN_WIDTH), D_MODEL ** -0.5)
    inputs['cmp_pos_k'] = nrm((DEPTH, CMP_BLOCK, NSA_HEAD_DIM), 0.02)
    inputs['cmp_pos_v'] = nrm((DEPTH, CMP_BLOCK, NSA_HEAD_DIM), 0.02)
    inputs['cmp_w1_k'] = nrm((DEPTH, CMP_BLOCK * NSA_HEAD_DIM, CMP_HIDDEN), (CMP_BLOCK * NSA_HEAD_DIM) ** -0.5)
    inputs['cmp_w2_k'] = nrm((DEPTH, CMP_HIDDEN, NSA_HEAD_DIM), CMP_HIDDEN ** -0.5)
    inputs['cmp_w1_v'] = nrm((DEPTH, CMP_BLOCK * NSA_HEAD_DIM, CMP_HIDDEN), (CMP_BLOCK * NSA_HEAD_DIM) ** -0.5)
    inputs['cmp_w2_v'] = nrm((DEPTH, CMP_HIDDEN, NSA_HEAD_DIM), CMP_HIDDEN ** -0.5)
    inputs['conv_w'] = nrm((DEPTH, CONV_WIDTH, 2 * MLSTM_QK_WIDTH), CONV_WIDTH ** -0.5)
    inputs['conv_b'] = nrm((DEPTH, 2 * MLSTM_QK_WIDTH), 0.01)
    forget_bias = jnp.broadcast_to(jnp.linspace(3.0, 6.0, MLSTM_HEADS), (DEPTH, MLSTM_HEADS))
    inputs['mlstm_gate_bias'] = jnp.stack([nrm((DEPTH, MLSTM_HEADS), 0.1),
                                           forget_bias + nrm((DEPTH, MLSTM_HEADS), 0.1)], axis=1)
    inputs['mlstm_norm'] = gain(MLSTM_WIDTH)
    inputs['w_out'] = nrm((DEPTH, MIX_WIDTH, D_MODEL), MIX_WIDTH ** -0.5)
    inputs['mix_norm_post'] = gain()
    inputs['xattn_norm_pre'] = gain()
    inputs['mem_norm'] = gain()
    inputs['w_xq'] = nrm((DEPTH, D_MODEL, D_MODEL), D_MODEL ** -0.5)
    inputs['w_xkv'] = nrm((DEPTH, D_MODEL, 2 * D_MODEL), D_MODEL ** -0.5)
    inputs['w_xo'] = nrm((DEPTH, D_MODEL, D_MODEL), D_MODEL ** -0.5)
    inputs['xattn_norm_post'] = gain()
    inputs['ffn_norm_pre'] = gain()
    inputs['w_gate_up'] = nrm((DEPTH, D_MODEL, 2 * D_FF), D_MODEL ** -0.5)
    inputs['w_down'] = nrm((DEPTH, D_FF, D_MODEL), D_FF ** -0.5)
    inputs['ffn_norm_post'] = gain()
    return inputs


def reference(x, mem, rel_bias, mix_norm_pre, w_in, cmp_pos_k, cmp_pos_v, cmp_w1_k, cmp_w2_k, cmp_w1_v,
              cmp_w2_v, conv_w, conv_b, mlstm_gate_bias, mlstm_norm, w_out, mix_norm_post, xattn_norm_pre,
              mem_norm, w_xq, w_xkv, w_xo, xattn_norm_post, ffn_norm_pre, w_gate_up, w_down, ffn_norm_post):
    for l in range(DEPTH):
        h = rms_norm(x, mix_norm_pre[l])
        y = hybrid_mixer(h, rel_bias, w_in[l], cmp_pos_k[l], cmp_pos_v[l], cmp_w1_k[l], cmp_w2_k[l],
                         cmp_w1_v[l], cmp_w2_v[l], conv_w[l], conv_b[l], mlstm_gate_bias[l], mlstm_norm[l], w_out[l])
        x = x + rms_norm(y, mix_norm_post[l])
        h = rms_norm(x, xattn_norm_pre[l])
        y = memory_cross_attention(h, rms_norm(mem, mem_norm[l]), w_xq[l], w_xkv[l], w_xo[l])
        x = x + rms_norm(y, xattn_norm_post[l])
        h = rms_norm(x, ffn_norm_pre[l])
        y = swiglu_ffn(h, w_gate_up[l], w_down[l])
        x = x + rms_norm(y, ffn_norm_post[l])
    return x
```

```cpp
#include <hip/hip_runtime.h>
#include <cstdio>
#include <cstdint>

#ifndef MK_ONE_LAUNCH
#define MK_ONE_LAUNCH 0
#endif

namespace pg8 {
#define PG8_LAS __attribute__((address_space(3)))
typedef unsigned short bf16_t;
typedef short bf16x8 __attribute__((ext_vector_type(8)));
typedef float f32x4 __attribute__((ext_vector_type(4)));
typedef unsigned u32x4 __attribute__((ext_vector_type(4)));
constexpr int BM = 256, BK = 64, HALF = 128, HTB = HALF * BK * 2, STAGE_BYTES = 8 * HTB, NXCD = 8, WGM = 8;

__host__ __device__ __forceinline__ int lds_byte(int r, int c) { const int st = (r >> 4) * 2 + (c >> 5), rr = r & 15, cc = c & 31, ob = rr * 64 + cc * 2; return st * 1024 + (ob ^ (((ob >> 9) & 1) << 5)); }
__host__ __device__ __forceinline__ void stage_rc(int b, int& R, int& C) { const int st = b / 1024, sb = b % 1024, swz = sb ^ (((sb >> 9) & 1) << 5); R = (st >> 1) * 16 + swz / 64; C = (st & 1) * 32 + (swz % 64) / 2; }
__host__ __device__ __forceinline__ int perm32(int rho) { const int n = rho >> 4, i = rho & 15; return 8 * (i >> 2) + 4 * n + (i & 3); }

struct Unit { int orow, ocol, bz; };
struct Gemm { const bf16_t* A; const bf16_t* Bt; int lda, ldb, K; };

struct GridOrder {
    int nM, nN, nwg, G, c, lda, ldb;
    __device__ void init(int M, int N, int lda_, int ldb_, int G_, int c_) { nM = M / BM; nN = N / BM; nwg = nM * nN; G = G_; c = c_; lda = lda_; ldb = ldb_; }
    __device__ bool next(int i, Unit& u) const {
        const long L = (long)i * G + c; if (L >= nwg) return false;
        int wgid = (int)L; { const int q = nwg / NXCD, r = nwg % NXCD, xcd = wgid % NXCD, off = wgid / NXCD; wgid = (xcd < r ? xcd * (q + 1) : r * (q + 1) + (xcd - r) * q) + off; }
        const int nig = WGM * nN, gid = wgid / nig, fm = gid * WGM, gsz = (nM - fm) < WGM ? (nM - fm) : WGM;
        const int pm = fm + ((wgid % nig) % gsz), pn = (wgid % nig) / gsz; u.bz = 0; u.orow = pm * BM; u.ocol = pn * BM; return true;
    }
    __device__ __forceinline__ long offA(const Unit& u) const { return (long)u.orow * lda; }
    __device__ __forceinline__ long offB(const Unit& u) const { return (long)u.ocol * ldb; }
};

__device__ __forceinline__ unsigned cvt_pk_bf16(float lo, float hi) { unsigned r; asm volatile("v_cvt_pk_bf16_f32 %0, %1, %2" : "=v"(r) : "v"(lo), "v"(hi)); return r; }
__device__ __forceinline__ float silu_f(float v) { return v / (1.0f + __expf(-v)); }

struct EpiBf16 {
    static constexpr bool PERM = true;
    bf16_t* O; int ldc; float scale;
    __device__ __forceinline__ void operator()(f32x4 (&acc)[2][2][4][2], const Unit& u, int wr, int wc, int fr, int fq) const {
        const int row0 = u.orow + wr * 64 + fr, col0 = u.ocol + wc * 32 + 8 * fq;
#pragma unroll
        for (int ai = 0; ai < 2; ++ai)
#pragma unroll
            for (int m = 0; m < 4; ++m) { bf16_t* rowp = O + (size_t)(row0 + ai * HALF + m * 16) * ldc + col0;
#pragma unroll
                for (int bj = 0; bj < 2; ++bj) { const f32x4 v0 = acc[ai][bj][m][0] * scale, v1 = acc[ai][bj][m][1] * scale;
                    u32x4 w; w.x = cvt_pk_bf16(v0[0], v0[1]); w.y = cvt_pk_bf16(v0[2], v0[3]); w.z = cvt_pk_bf16(v1[0], v1[1]); w.w = cvt_pk_bf16(v1[2], v1[3]);
                    *(u32x4*)(rowp + bj * HALF) = w; } }
    }
};
struct EpiF32 {
    static constexpr bool PERM = false;
    float* O; int ldc;
    __device__ __forceinline__ void operator()(f32x4 (&acc)[2][2][4][2], const Unit& u, int wr, int wc, int fr, int fq) const {
        const int row0 = u.orow + wr * 64 + fr, col0 = u.ocol + wc * 32 + 4 * fq;
#pragma unroll
        for (int ai = 0; ai < 2; ++ai)
#pragma unroll
            for (int m = 0; m < 4; ++m) { float* rowp = O + (size_t)(row0 + ai * HALF + m * 16) * ldc + col0;
#pragma unroll
                for (int bj = 0; bj < 2; ++bj)
#pragma unroll
                    for (int n = 0; n < 2; ++n) *(f32x4*)(rowp + bj * HALF + n * 16) = acc[ai][bj][m][n]; }
    }
};
struct EpiSiluBias {
    static constexpr bool PERM = true;
    bf16_t* O; int ldc; const float* bias;
    __device__ __forceinline__ void operator()(f32x4 (&acc)[2][2][4][2], const Unit& u, int wr, int wc, int fr, int fq) const {
        const int row0 = u.orow + wr * 64 + fr, col0 = u.ocol + wc * 32 + 8 * fq; const float* bp = bias + u.bz * 256 + wc * 32 + 8 * fq;
        f32x4 bv[2][2];
#pragma unroll
        for (int bj = 0; bj < 2; ++bj)
#pragma unroll
            for (int n = 0; n < 2; ++n) bv[bj][n] = *(const f32x4*)(bp + bj * HALF + 4 * n);
#pragma unroll
        for (int ai = 0; ai < 2; ++ai)
#pragma unroll
            for (int m = 0; m < 4; ++m) { bf16_t* rowp = O + (size_t)(row0 + ai * HALF + m * 16) * ldc + col0;
#pragma unroll
                for (int bj = 0; bj < 2; ++bj) { f32x4 v0 = acc[ai][bj][m][0] + bv[bj][0], v1 = acc[ai][bj][m][1] + bv[bj][1];
#pragma unroll
                    for (int i = 0; i < 4; ++i) { v0[i] = silu_f(v0[i]); v1[i] = silu_f(v1[i]); }
                    u32x4 w; w.x = cvt_pk_bf16(v0[0], v0[1]); w.y = cvt_pk_bf16(v0[2], v0[3]); w.z = cvt_pk_bf16(v1[0], v1[1]); w.w = cvt_pk_bf16(v1[2], v1[3]);
                    *(u32x4*)(rowp + bj * HALF) = w; } }
    }
};
struct EpiSwiglu {
    static constexpr bool PERM = true;
    bf16_t* O; int ldc;
    __device__ __forceinline__ void operator()(f32x4 (&acc)[2][2][4][2], const Unit& u, int wr, int wc, int fr, int fq) const {
        const int row0 = u.orow + wr * 64 + fr, col0 = (u.ocol >> 1) + wc * 32 + 8 * fq;
#pragma unroll
        for (int ai = 0; ai < 2; ++ai)
#pragma unroll
            for (int m = 0; m < 4; ++m) { bf16_t* rowp = O + (size_t)(row0 + ai * HALF + m * 16) * ldc + col0;
                f32x4 v0, v1;
#pragma unroll
                for (int i = 0; i < 4; ++i) { v0[i] = silu_f(acc[ai][0][m][0][i]) * acc[ai][1][m][0][i]; v1[i] = silu_f(acc[ai][0][m][1][i]) * acc[ai][1][m][1][i]; }
                u32x4 w; w.x = cvt_pk_bf16(v0[0], v0[1]); w.y = cvt_pk_bf16(v0[2], v0[3]); w.z = cvt_pk_bf16(v1[0], v1[1]); w.w = cvt_pk_bf16(v1[2], v1[3]);
                *(u32x4*)rowp = w; }
    }
};
template <class Epi, class Sched, bool ALIGN_EPI, bool SP2>
__device__ __forceinline__ void gemm_phase(PG8_LAS unsigned char* lds, const Gemm g, const Sched& S, const Epi& E) {
    int tid_ = threadIdx.x; asm volatile("" : "+v"(tid_));
    const int tid = tid_, wid = __builtin_amdgcn_readfirstlane(tid >> 6), lane = tid & 63, wr = wid >> 2, wc = wid & 3, fr = lane & 15, fq = lane >> 4;
    const int K = g.K, nt = K / BK;
    unsigned voffA[2], voffB[2];
#pragma unroll
    for (int i = 0; i < 2; ++i) { int R, C; stage_rc(tid * 16 + i * 8192, R, C); const int Rb = Epi::PERM ? ((R & ~31) + perm32(R & 31)) : R;
        voffA[i] = (unsigned)(R * g.lda + C) * 2u; voffB[i] = (unsigned)(Rb * g.ldb + C) * 2u; }
    const size_t kstep = (size_t)(BK * 2);
    const size_t hstepA = (size_t)HALF * g.lda * 2, hstepB = (size_t)HALF * g.ldb * 2;
    const unsigned ldsw = (unsigned)wid * 1024u;
    const int aoff = lds_byte(wr * 64 + fr, fq * 8), boff = lds_byte(wc * 32 + fr, fq * 8);
#define PG8_SA(b, h) (((b) * 2 + (h)) * HTB)
#define PG8_SB(b, h) ((4 + (b) * 2 + (h)) * HTB)
#define PG8_STAGE(bufoff, gbase, voff) do { _Pragma("unroll") for (int _i = 0; _i < 2; ++_i) \
        __builtin_amdgcn_global_load_lds((const unsigned*)((const char*)(gbase) + (voff)[_i]), (PG8_LAS unsigned*)(lds + (bufoff) + ldsw + _i * 8192), 16, 0, 0); } while (0)
#define PG8_LDA(dst, b, h) do { _Pragma("unroll") for (int m = 0; m < 4; ++m) _Pragma("unroll") for (int k = 0; k < 2; ++k) dst[m][k] = *(const PG8_LAS bf16x8*)(lds + PG8_SA(b, h) + aoff + m * 2048 + k * 1024); } while (0)
#define PG8_LDB(dst, b, h) do { _Pragma("unroll") for (int n = 0; n < 2; ++n) _Pragma("unroll") for (int k = 0; k < 2; ++k) dst[n][k] = *(const PG8_LAS bf16x8*)(lds + PG8_SB(b, h) + boff + n * 2048 + k * 1024); } while (0)
#define PG8_MMA(ai, bj, At, Bt) do { __builtin_amdgcn_s_setprio(1); _Pragma("unroll") for (int m = 0; m < 4; ++m) _Pragma("unroll") for (int n = 0; n < 2; ++n) _Pragma("unroll") for (int k = 0; k < 2; ++k) \
        acc[ai][bj][m][n] = __builtin_amdgcn_mfma_f32_16x16x32_bf16(Bt[n][k], At[m][k], acc[ai][bj][m][n], 0, 0, 0); __builtin_amdgcn_s_setprio(0); } while (0)
#define PG8_WAIT_V(n) asm volatile("s_waitcnt vmcnt(" #n ")" ::: "memory")
#define PG8_WAIT_L(n) asm volatile("s_waitcnt lgkmcnt(" #n ")" ::: "memory")
#define PG8_BAR __builtin_amdgcn_s_barrier()
#define PG8_SCHED __builtin_amdgcn_sched_barrier(0)
    Unit cur, nxt; int ui = 0;
    if (!S.next(0, cur)) return;
    f32x4 acc[2][2][4][2];
#pragma unroll
    for (int a = 0; a < 2; ++a)
#pragma unroll
        for (int b = 0; b < 2; ++b)
#pragma unroll
            for (int m = 0; m < 4; ++m)
#pragma unroll
                for (int n = 0; n < 2; ++n) acc[a][b][m][n] = (f32x4){0.f, 0.f, 0.f, 0.f};
    bf16x8 At[4][2], B0[2][2], B1[2][2];
    const char* cA = (const char*)g.A + (size_t)S.offA(cur) * 2; const char* cB = (const char*)g.Bt + (size_t)S.offB(cur) * 2;
    if constexpr (SP2) {
        PG8_STAGE(PG8_SB(0, 0), cB, voffB); PG8_STAGE(PG8_SB(0, 1), cB + hstepB, voffB); PG8_STAGE(PG8_SA(0, 0), cA, voffA); PG8_STAGE(PG8_SA(0, 1), cA + hstepA, voffA);
        if (wr == 1) PG8_BAR;
        PG8_WAIT_V(2); PG8_BAR;
        PG8_STAGE(PG8_SB(1, 0), cB + kstep, voffB); PG8_STAGE(PG8_SA(1, 0), cA + kstep, voffA); PG8_STAGE(PG8_SB(1, 1), cB + hstepB + kstep, voffB);
        PG8_WAIT_V(6); PG8_BAR;
    } else {
        PG8_STAGE(PG8_SB(0, 0), cB, voffB); PG8_STAGE(PG8_SA(0, 0), cA, voffA); PG8_STAGE(PG8_SB(0, 1), cB + hstepB, voffB); PG8_STAGE(PG8_SA(0, 1), cA + hstepA, voffA);
        if (wr == 1) PG8_BAR;
        PG8_WAIT_V(4); PG8_BAR;
        PG8_STAGE(PG8_SB(1, 0), cB + kstep, voffB); PG8_STAGE(PG8_SA(1, 0), cA + kstep, voffA); PG8_STAGE(PG8_SB(1, 1), cB + hstepB + kstep, voffB);
        PG8_WAIT_V(6); PG8_BAR;
    }
    for (;;) {
        const bool has_next = S.next(ui + 1, nxt);
        const char* nA = has_next ? (const char*)g.A + (size_t)S.offA(nxt) * 2 : cA; const char* nB = has_next ? (const char*)g.Bt + (size_t)S.offB(nxt) * 2 : cB;
#pragma unroll 1
        for (int t = 0; t < nt; t += 2) {
            const bool last = (t == nt - 2);
            const char* a1 = cA + (size_t)(t + 1) * kstep;
            const char* a2 = last ? nA : cA + (size_t)(t + 2) * kstep; const char* b2 = last ? nB : cB + (size_t)(t + 2) * kstep;
            const char* a3 = a2 + kstep; const char* b3 = b2 + kstep;
            if constexpr (SP2) {
            PG8_LDB(B0, 0, 0); PG8_LDB(B1, 0, 1); PG8_SCHED; PG8_LDA(At, 0, 0); PG8_STAGE(PG8_SA(1, 1), a1 + hstepA, voffA);
            PG8_WAIT_V(8); PG8_WAIT_L(0); PG8_BAR; PG8_MMA(0, 0, At, B0); PG8_MMA(0, 1, At, B1); PG8_BAR; PG8_SCHED;
            PG8_LDA(At, 0, 1); PG8_STAGE(PG8_SB(0, 0), b2, voffB); PG8_STAGE(PG8_SB(0, 1), b2 + hstepB, voffB); PG8_STAGE(PG8_SA(0, 0), a2, voffA);
            PG8_WAIT_V(8); PG8_WAIT_L(0); PG8_BAR; PG8_MMA(1, 0, At, B0); PG8_MMA(1, 1, At, B1); PG8_BAR; PG8_SCHED;
            PG8_LDB(B0, 1, 0); PG8_LDB(B1, 1, 1); PG8_SCHED; PG8_LDA(At, 1, 0); PG8_STAGE(PG8_SA(0, 1), a2 + hstepA, voffA);
            PG8_WAIT_V(8); PG8_WAIT_L(0); PG8_BAR; PG8_MMA(0, 0, At, B0); PG8_MMA(0, 1, At, B1); PG8_BAR; PG8_SCHED;
            PG8_LDA(At, 1, 1); PG8_STAGE(PG8_SB(1, 0), b3, voffB); PG8_STAGE(PG8_SB(1, 1), b3 + hstepB, voffB); PG8_STAGE(PG8_SA(1, 0), a3, voffA);
            PG8_WAIT_V(8); PG8_WAIT_L(0); PG8_BAR; PG8_MMA(1, 0, At, B0); PG8_MMA(1, 1, At, B1); PG8_BAR; PG8_SCHED;
            } else {
            PG8_LDB(B0, 0, 0); PG8_SCHED; PG8_LDA(At, 0, 0); PG8_STAGE(PG8_SA(1, 1), a1 + hstepA, voffA);
            PG8_WAIT_L(8); PG8_BAR; PG8_WAIT_L(0); PG8_MMA(0, 0, At, B0); PG8_BAR; PG8_SCHED;
            PG8_LDB(B1, 0, 1); PG8_STAGE(PG8_SB(0, 0), b2, voffB);
            PG8_BAR; PG8_WAIT_L(0); PG8_MMA(0, 1, At, B1); PG8_BAR;
            PG8_LDA(At, 0, 1); PG8_STAGE(PG8_SA(0, 0), a2, voffA);
            PG8_BAR; PG8_WAIT_L(0); PG8_MMA(1, 0, At, B0); PG8_BAR; PG8_SCHED;
            PG8_STAGE(PG8_SB(0, 1), b2 + hstepB, voffB);
            PG8_WAIT_V(6); PG8_BAR; PG8_MMA(1, 1, At, B1); PG8_BAR;
            PG8_LDB(B0, 1, 0); PG8_SCHED; PG8_LDA(At, 1, 0); PG8_STAGE(PG8_SA(0, 1), a2 + hstepA, voffA);
            PG8_WAIT_L(8); PG8_BAR; PG8_WAIT_L(0); PG8_MMA(0, 0, At, B0); PG8_BAR; PG8_SCHED;
            PG8_LDB(B1, 1, 1); PG8_STAGE(PG8_SB(1, 0), b3, voffB);
            PG8_BAR; PG8_WAIT_L(0); PG8_MMA(0, 1, At, B1); PG8_BAR;
            PG8_LDA(At, 1, 1); PG8_STAGE(PG8_SA(1, 0), a3, voffA);
            PG8_BAR; PG8_WAIT_L(0); PG8_MMA(1, 0, At, B0); PG8_BAR; PG8_SCHED;
            PG8_STAGE(PG8_SB(1, 1), b3 + hstepB, voffB);
            PG8_WAIT_V(6); PG8_BAR; PG8_MMA(1, 1, At, B1); PG8_BAR;
            }
        }
        if constexpr (ALIGN_EPI) { if (wr == 0) PG8_BAR; }
        E(acc, cur, wr, wc, fr, fq);
        if (!has_next) break;
#pragma unroll
        for (int a = 0; a < 2; ++a)
#pragma unroll
            for (int b = 0; b < 2; ++b)
#pragma unroll
                for (int m = 0; m < 4; ++m)
#pragma unroll
                    for (int n = 0; n < 2; ++n) acc[a][b][m][n] = (f32x4){0.f, 0.f, 0.f, 0.f};
        cur = nxt; cA = nA; cB = nB; ++ui;
        if constexpr (ALIGN_EPI) { if (wr == 1) PG8_BAR; }
    }
    PG8_WAIT_V(0);
    if constexpr (!ALIGN_EPI) { if (wr == 0) PG8_BAR; }
    PG8_BAR;
#undef PG8_SA
#undef PG8_SB
#undef PG8_STAGE
#undef PG8_LDA
#undef PG8_LDB
#undef PG8_MMA
#undef PG8_WAIT_V
#undef PG8_WAIT_L
#undef PG8_BAR
#undef PG8_SCHED
}
}

constexpr int NWAVES = 8;
constexpr int BATCH = 8, SEQ = 4096, D = 1024, T = BATCH * SEQ;
constexpr int NPROJ = 2848, NPROJ_PAD = 3072, DFF = 2816, MEMT = 256;
constexpr int C_NQ = 0, C_KC = 512, C_VC = 640, C_KSL = 768, C_VSL = 896, C_KWN = 1024, C_VWN = 1152, C_GT = 1280, C_MQ = 1304, C_MK = 1560, C_MV = 1816, C_MI = 2328, C_MF = 2332, C_MO = 2336;
constexpr float EPS = 1e-6f;
constexpr int NPHASE = 17;

constexpr size_t MiB = 1u << 20;
constexpr size_t WS_CTL = 0, CTL_ZERO_BYTES = 1 * MiB;
constexpr size_t WS_WIN = 2 * MiB, WS_WOUT = 8 * MiB, WS_WXQ = 10 * MiB, WS_WXKV = 12 * MiB, WS_WXO = 16 * MiB, WS_WGU = 18 * MiB, WS_WDN = 29 * MiB, WS_WC1 = 35 * MiB;
constexpr size_t WS_MEMN = 37 * MiB, WS_MEMK = 41 * MiB, WS_VT = 45 * MiB, WS_CKV = 49 * MiB, WS_HID = 58 * MiB, WS_KCMP = 62 * MiB;
constexpr size_t WS_H = 64 * MiB, WS_PROJ = 128 * MiB, WS_Y1 = 128 * MiB, WS_ACT = 128 * MiB, WS_YMIX = 320 * MiB, WS_QX = 320 * MiB, WS_Y2 = 320 * MiB, WS_OX = 384 * MiB, WS_CU = 384 * MiB;
constexpr size_t WS_P = 448 * MiB, WS_MQK = 448 * MiB, WS_SMALL = 480 * MiB, WS_END = 512 * MiB;
constexpr size_t SM_BC = 0, SM_GC = 1 * MiB, SM_PM = 2 * MiB, SM_NU = 3 * MiB, SM_MST = 4 * MiB, SM_DEC = 4 * MiB + 65536;
constexpr int CW_TMO = 0, CW_BAR = 4096, CW_CB1 = 16384;

constexpr int RING_BYTES = 131072, LDSCTL_OFF = RING_BYTES, MISC_OFF = LDSCTL_OFF + 320, SCR_OFF = RING_BYTES + 512, LDS_BYTES = 147456;

#define GAS __attribute__((address_space(1)))
#define LAS __attribute__((address_space(3)))
typedef unsigned short bf16;
typedef unsigned v4u __attribute__((ext_vector_type(4)));
typedef float f32x4 __attribute__((ext_vector_type(4)));
typedef GAS unsigned gu32;
#define RLX_AGENT __ATOMIC_RELAXED, __HIP_MEMORY_SCOPE_AGENT
#define LDS_WAIT() asm volatile("s_waitcnt lgkmcnt(0)" ::: "memory")
__device__ __forceinline__ unsigned f2bf(float f) { unsigned u = __builtin_bit_cast(unsigned, f); return (u + 0x7fffu + ((u >> 16) & 1u)) >> 16; }
__device__ __forceinline__ unsigned pk2(float lo, float hi) { return f2bf(lo) | (f2bf(hi) << 16); }
__device__ __forceinline__ float bf2f(unsigned short h) { return __uint_as_float(((unsigned)h) << 16); }
__device__ __forceinline__ float bflo(unsigned w) { return __uint_as_float(w << 16); }
__device__ __forceinline__ float bfhi(unsigned w) { return __uint_as_float(w & 0xffff0000u); }
__device__ __forceinline__ float sigmoid_f(float v) { return 1.0f / (1.0f + __expf(-v)); }

#define XB_TMO      128
#define XB_XCNT(j)  (256  + 64 * (j))
#define XB_XSUB(j)  (1280 + 64 * (j))
#define XB_XGEN(j)  (2304 + 64 * (j))
#define XB_TOP      3328
#define XB_TOPGEN   3392
#define XCD_BAR_WORDS 3456
#define XB_SPIN_CAP (1u << 18)
__device__ __forceinline__ unsigned xb_ld(unsigned* p)              { return __hip_atomic_load(p, __ATOMIC_RELAXED, __HIP_MEMORY_SCOPE_AGENT); }
__device__ __forceinline__ unsigned xb_add(unsigned* p, unsigned v) { return __hip_atomic_fetch_add(p, v, __ATOMIC_RELAXED, __HIP_MEMORY_SCOPE_AGENT); }
__device__ __forceinline__ unsigned xb_xcc_id() { return (unsigned)__builtin_amdgcn_s_getreg((3 << 11) | 20) & 0xFu; }
#define XB_SPIN(cond, bar) do { unsigned _sp = 0; while (cond) { __builtin_amdgcn_s_sleep(1); \
    if ((++_sp & 255u) == 0u) { if (xb_ld(&(bar)[XB_TMO])) break; if (_sp > XB_SPIN_CAP) { atomicAdd(&(bar)[XB_TMO], 1u); break; } } } } while (0)
struct XcdBarrier { unsigned* bar; unsigned x; volatile LAS unsigned* st; };
__device__ __forceinline__ XcdBarrier xcd_barrier_post(unsigned* bar, volatile LAS unsigned* st) {
    XcdBarrier b; b.bar = bar; b.x = xb_xcc_id(); b.st = st;
    if (threadIdx.x == 0) (void)xb_add(&bar[XB_XCNT(b.x)], 1u);
    return b;
}
__device__ __forceinline__ void xcd_barrier_complete(unsigned* bar, unsigned x, unsigned& nloc, unsigned& nx) {
    const unsigned G = gridDim.x * gridDim.y * gridDim.z;
    unsigned sum, cnt, mine, sp = 0u;
    for (;;) {
        sum = 0u; cnt = 0u; mine = 0u;
#pragma unroll
        for (unsigned j = 0; j < 16; ++j) { const unsigned c = xb_ld(&bar[XB_XCNT(j)]); sum += c; cnt += (c > 0u) ? 1u : 0u; mine = (j == x) ? c : mine; }
        if (sum == G) break;
        __builtin_amdgcn_s_sleep(1);
        if ((++sp & 255u) == 0u) { if (xb_ld(&bar[XB_TMO])) break; if (sp > XB_SPIN_CAP) { atomicAdd(&bar[XB_TMO], 1u); break; } }
    }
    nloc = mine > 0u ? mine : 1u; nx = cnt > 0u ? cnt : 1u;
}
__device__ __forceinline__ void xcd_barrier(const XcdBarrier& b) {
    asm volatile("s_waitcnt vmcnt(0)" ::: "memory");
    __syncthreads();
    if (threadIdx.x == 0) {
        unsigned* bar = b.bar;
        __builtin_amdgcn_s_waitcnt(0);
        unsigned nloc = b.st[0], nx = b.st[1];
        if (nloc == 0u) { xcd_barrier_complete(bar, b.x, nloc, nx); b.st[0] = nloc; b.st[1] = nx; }
        const unsigned old = xb_add(&bar[XB_XSUB(b.x)], 1u);
        const unsigned gen = old / nloc;
        if (old + 1u == (gen + 1u) * nloc) {
            __builtin_amdgcn_fence(__ATOMIC_RELEASE, "agent");
            asm volatile("s_waitcnt vmcnt(0)" ::: "memory");
            const unsigned og = xb_add(&bar[XB_TOP], 1u);
            const unsigned tg = og / nx;
            if (og + 1u == (tg + 1u) * nx) xb_add(&bar[XB_TOPGEN], 1u);
            else XB_SPIN(xb_ld(&bar[XB_TOPGEN]) == tg, bar);
            __builtin_amdgcn_fence(__ATOMIC_ACQUIRE, "agent");
            xb_add(&bar[XB_XGEN(b.x)], 1u);
            asm volatile("s_waitcnt vmcnt(0)" ::: "memory");
        } else {
            XB_SPIN(xb_ld(&bar[XB_XGEN(b.x)]) == gen, bar);
            __builtin_amdgcn_fence(__ATOMIC_ACQUIRE, "agent");
            asm volatile("s_waitcnt vmcnt(0)" ::: "memory");
        }
    }
    __syncthreads();
}

__device__ __forceinline__ float wave_sum(float v) {
#pragma unroll
    for (int o = 1; o < 64; o <<= 1) v += __shfl_xor(v, o);
    return v;
}
__device__ __forceinline__ float wave_max(float v) {
#pragma unroll
    for (int o = 1; o < 64; o <<= 1) v = fmaxf(v, __shfl_xor(v, o));
    return v;
}
__device__ const unsigned char kBucket[129] = {
    0, 1, 2, 3, 4, 5, 6, 7, 8, 9, 10, 11, 12, 13, 14, 15, 16, 16, 16, 17, 17, 18, 18, 18, 19, 19, 19, 20, 20, 20, 20, 21, 21, 21, 21, 22, 22, 22, 22, 22,
    23, 23, 23, 23, 23, 23, 24, 24, 24, 24, 24, 24, 25, 25, 25, 25, 25, 25, 25, 26, 26, 26, 26, 26, 26, 26, 26, 27, 27, 27, 27, 27, 27, 27, 27, 27, 27,
    28, 28, 28, 28, 28, 28, 28, 28, 28, 28, 29, 29, 29, 29, 29, 29, 29, 29, 29, 29, 29, 29, 30, 30, 30, 30, 30, 30, 30, 30, 30, 30, 30, 30, 30, 30,
    31, 31, 31, 31, 31, 31, 31, 31, 31, 31, 31, 31, 31, 31, 31, 31};

__device__ __forceinline__ void transpose_item(const float* W, int N, bf16* WT, int ldt, int k0, int n0, int drow0, LAS float* scr, int lane) {
#pragma unroll 8
    for (int i = 0; i < 32; ++i) { const int kk = 2 * i + (lane >> 5); scr[kk * 33 + (lane & 31)] = W[(size_t)(k0 + kk) * N + n0 + (lane & 31)]; }
    LDS_WAIT(); asm volatile("" ::: "memory");
    const int c = lane & 7;
#pragma unroll
    for (int j = 0; j < 4; ++j) { const int n = (lane >> 3) + 8 * j; const LAS float* s = scr + (8 * c) * 33 + n;
        v4u o; o.x = pk2(s[0 * 33], s[1 * 33]); o.y = pk2(s[2 * 33], s[3 * 33]); o.z = pk2(s[4 * 33], s[5 * 33]); o.w = pk2(s[6 * 33], s[7 * 33]);
        *(GAS v4u*)(WT + (size_t)(drow0 + n) * ldt + k0 + 8 * c) = o; }
    LDS_WAIT(); asm volatile("" ::: "memory");
}
__device__ __forceinline__ void rms_row_to_bf16(const float* xrow, const float* gain, bf16* orow, int lane) {
    const GAS f32x4* xr = (const GAS f32x4*)xrow + lane; const GAS f32x4* gr = (const GAS f32x4*)gain + lane;
    f32x4 v[4]; float s = 0.f;
#pragma unroll
    for (int j = 0; j < 4; ++j) { v[j] = xr[64 * j]; s += (v[j].x * v[j].x + v[j].y * v[j].y) + (v[j].z * v[j].z + v[j].w * v[j].w); }
    const float rstd = 1.f / sqrtf(wave_sum(s) * (1.f / D) + EPS);
    GAS unsigned long long* o8 = (GAS unsigned long long*)orow + lane;
#pragma unroll
    for (int j = 0; j < 4; ++j) { const f32x4 g = gr[64 * j];
        o8[64 * j] = (unsigned long long)pk2(v[j].x * rstd * g.x, v[j].y * rstd * g.y) | ((unsigned long long)pk2(v[j].z * rstd * g.z, v[j].w * rstd * g.w) << 32); }
}
__device__ __forceinline__ void resnorm_row(const float* yrow, const float* xi, const float* gpost, float* xo, const float* gpre, bf16* ho, int lane) {
    const GAS f32x4* yr = (const GAS f32x4*)yrow + lane; const GAS f32x4* xr = (const GAS f32x4*)xi + lane; const GAS f32x4* gr = (const GAS f32x4*)gpost + lane;
    f32x4 v[4], x[4]; float s = 0.f;
#pragma unroll
    for (int j = 0; j < 4; ++j) { v[j] = yr[64 * j]; x[j] = xr[64 * j]; s += (v[j].x * v[j].x + v[j].y * v[j].y) + (v[j].z * v[j].z + v[j].w * v[j].w); }
    const float rstd = 1.f / sqrtf(wave_sum(s) * (1.f / D) + EPS);
    float s2 = 0.f;
#pragma unroll
    for (int j = 0; j < 4; ++j) { const f32x4 g = gr[64 * j]; x[j] = x[j] + v[j] * rstd * g; s2 += (x[j].x * x[j].x + x[j].y * x[j].y) + (x[j].z * x[j].z + x[j].w * x[j].w); }
    GAS f32x4* xw = (GAS f32x4*)xo + lane;
#pragma unroll
    for (int j = 0; j < 4; ++j) xw[64 * j] = x[j];
    if (gpre) {
        const float rstd2 = 1.f / sqrtf(wave_sum(s2) * (1.f / D) + EPS);
        const GAS f32x4* g2 = (const GAS f32x4*)gpre + lane; GAS unsigned long long* o8 = (GAS unsigned long long*)ho + lane;
#pragma unroll
        for (int j = 0; j < 4; ++j) { const f32x4 g = g2[64 * j];
            o8[64 * j] = (unsigned long long)pk2(x[j].x * rstd2 * g.x, x[j].y * rstd2 * g.y) | ((unsigned long long)pk2(x[j].z * rstd2 * g.z, x[j].w * rstd2 * g.w) << 32); }
    }
}

struct XaSOrder {
    int G, c;
    __device__ bool next(int i, pg8::Unit& u) const {
        const int L = i * G + c; if (L >= 512) return false;
        const int bz = L >> 4, pm = L & 15, b = bz >> 2, h = bz & 3;
        u.bz = bz; u.orow = b * SEQ + pm * 256; u.ocol = h * 256; return true;
    }
    __device__ __forceinline__ long offA(const pg8::Unit& u) const { return (long)u.orow * D + u.ocol; }
    __device__ __forceinline__ long offB(const pg8::Unit& u) const { return (long)((u.bz >> 2) * MEMT) * D + u.ocol; }
};
struct XaPVOrder {
    int G, c;
    __device__ bool next(int i, pg8::Unit& u) const {
        const int L = i * G + c; if (L >= 512) return false;
        const int bz = L >> 4, pm = L & 15, b = bz >> 2, h = bz & 3;
        u.bz = bz; u.orow = b * SEQ + pm * 256; u.ocol = h * 256; return true;
    }
    __device__ __forceinline__ long offA(const pg8::Unit& u) const { return (long)u.orow * D + u.ocol; }
    __device__ __forceinline__ long offB(const pg8::Unit& u) const { return (long)u.ocol * (BATCH * MEMT) + (u.bz >> 2) * MEMT; }
};
struct CmpOrder {
    int G, c;
    __device__ bool next(int i, pg8::Unit& u) const {
        const int L = i * G + c; if (L >= 32) return false;
        const int kv = L >> 4, pm = L & 15;
        u.bz = kv; u.orow = kv * 4096 + pm * 256; u.ocol = 0; return true;
    }
    __device__ __forceinline__ long offA(const pg8::Unit& u) const { return (long)u.orow * 1024; }
    __device__ __forceinline__ long offB(const pg8::Unit& u) const { return (long)u.bz * 256 * 2048; }
};

struct Args { const float* in[27]; float* out; unsigned char* ws; int ph_lo, ph_hi; };
__global__ void __launch_bounds__(NWAVES * 64, 2) hymba_fwd(Args args) {
    extern __shared__ __attribute__((aligned(16))) unsigned char lds_raw[];
    LAS unsigned char* lds = (LAS unsigned char*)lds_raw;
    volatile LAS unsigned* MISC = (volatile LAS unsigned*)(lds + MISC_OFF);
    const int tid = threadIdx.x, lane = tid & 63, wave = __builtin_amdgcn_readfirstlane(tid >> 6);
    const int G = gridDim.x; const int bx = blockIdx.x; const int vcu = (G % 8 == 0) ? (bx % 8) * (G / 8) + bx / 8 : bx;
    const int gw = vcu * NWAVES + wave, NGW = G * NWAVES;
    const long gtid = (long)vcu * 512 + tid, NGT = (long)G * 512;
    unsigned char* ws = args.ws;
    gu32* ctl = (gu32*)(ws + WS_CTL);
#define x_in ((const float*)args.in[0])
#define mem_in ((const float*)args.in[1])
#define rel_bias ((const float*)args.in[2])
#define g_mix_pre ((const float*)args.in[3])
#define w_in ((const float*)args.in[4])
#define cmp_pos_k ((const float*)args.in[5])
#define cmp_pos_v ((const float*)args.in[6])
#define cmp_w1_k ((const float*)args.in[7])
#define cmp_w2_k ((const float*)args.in[8])
#define cmp_w1_v ((const float*)args.in[9])
#define cmp_w2_v ((const float*)args.in[10])
#define conv_w ((const float*)args.in[11])
#define conv_b ((const float*)args.in[12])
#define gate_bias ((const float*)args.in[13])
#define mlstm_norm ((const float*)args.in[14])
#define w_out ((const float*)args.in[15])
#define g_mix_post ((const float*)args.in[16])
#define g_x_pre ((const float*)args.in[17])
#define g_mem ((const float*)args.in[18])
#define w_xq ((const float*)args.in[19])
#define w_xkv ((const float*)args.in[20])
#define w_xo ((const float*)args.in[21])
#define g_x_post ((const float*)args.in[22])
#define g_ffn_pre ((const float*)args.in[23])
#define w_gate_up ((const float*)args.in[24])
#define w_down ((const float*)args.in[25])
#define g_ffn_post ((const float*)args.in[26])
#define out_p (args.out)
#define Win_t ((bf16*)(ws + WS_WIN))
#define Wout_t ((bf16*)(ws + WS_WOUT))
#define Wxq_t ((bf16*)(ws + WS_WXQ))
#define Wxkv_t ((bf16*)(ws + WS_WXKV))
#define Wxo_t ((bf16*)(ws + WS_WXO))
#define Wgu_t ((bf16*)(ws + WS_WGU))
#define Wdn_t ((bf16*)(ws + WS_WDN))
#define Wc1_t ((bf16*)(ws + WS_WC1))
#define MEMN ((bf16*)(ws + WS_MEMN))
#define MEMK ((bf16*)(ws + WS_MEMK))
#define VT ((bf16*)(ws + WS_VT))
#define CKV ((bf16*)(ws + WS_CKV))
#define HID ((bf16*)(ws + WS_HID))
#define KCMP ((float*)(ws + WS_KCMP))
#define H ((bf16*)(ws + WS_H))
#define PROJ ((bf16*)(ws + WS_PROJ))
#define Y1 ((float*)(ws + WS_Y1))
#define ACT ((bf16*)(ws + WS_ACT))
#define YMIX ((bf16*)(ws + WS_YMIX))
#define QX ((bf16*)(ws + WS_QX))
#define Y2 ((float*)(ws + WS_Y2))
#define OX ((bf16*)(ws + WS_OX))
#define CU ((float*)(ws + WS_CU))
#define PB ((bf16*)(ws + WS_P))
#define MQK ((bf16*)(ws + WS_MQK))
#define Bc ((float*)(ws + WS_SMALL + SM_BC))
#define Gc ((float*)(ws + WS_SMALL + SM_GC))
#define PM ((float*)(ws + WS_SMALL + SM_PM))
#define NU ((float*)(ws + WS_SMALL + SM_NU))
#define MST ((float*)(ws + WS_SMALL + SM_MST))
#define DEC ((float*)(ws + WS_SMALL + SM_DEC))
#define CB1 ((float*)(ws + WS_CTL) + CW_CB1)
    for (int u = tid; u < (LDS_BYTES - LDSCTL_OFF) / 4; u += NWAVES * 64) ((LAS unsigned*)(lds + LDSCTL_OFF))[u] = 0u;
    __syncthreads();
    XcdBarrier bar; bar.bar = (unsigned*)ctl + CW_BAR; bar.x = 0; bar.st = nullptr;
    if (MK_ONE_LAUNCH) bar = xcd_barrier_post((unsigned*)ctl + CW_BAR, MISC + 8);
    const int lo = args.ph_lo, hi = args.ph_hi;
#if defined(DBG_MASK)
#define IN(k) (((DBG_MASK >> (k)) & 1) && lo <= (k) && (k) < hi)
#elif defined(DBG_ONLY)
#define IN(k) ((k) == DBG_ONLY && lo <= (k) && (k) < hi)
#else
#define IN(k) (lo <= (k) && (k) < hi)
#endif
#define SEAM(k) do { if (MK_ONE_LAUNCH && IN(k) && IN((k) + 1)) xcd_barrier(bar); } while (0)

    if (IN(0)) {
        LAS float* scr = (LAS float*)(lds + wave * 16384);
        constexpr int I_IN = 16 * 89, I_SQ = 16 * 32, I_KV = 16 * 64, I_GU = 16 * 176, I_DN = 44 * 32, I_C1 = 32 * 8;
        constexpr int NITEMS = I_IN + 3 * I_SQ + I_KV + I_GU + I_DN + 2 * I_C1;
        for (int it = gw; it < NITEMS; it += NGW) {
            int r = it;
            if (r < I_IN) { const int kb = r / 89, nb = r % 89; transpose_item(w_in, NPROJ, Win_t, D, 64 * kb, 32 * nb, 32 * nb, scr, lane); continue; } r -= I_IN;
            if (r < I_SQ) { const int kb = r / 32, nb = r % 32; transpose_item(w_out, D, Wout_t, D, 64 * kb, 32 * nb, 32 * nb, scr, lane); continue; } r -= I_SQ;
            if (r < I_SQ) { const int kb = r / 32, nb = r % 32; transpose_item(w_xq, D, Wxq_t, D, 64 * kb, 32 * nb, 32 * nb, scr, lane); continue; } r -= I_SQ;
            if (r < I_SQ) { const int kb = r / 32, nb = r % 32; transpose_item(w_xo, D, Wxo_t, D, 64 * kb, 32 * nb, 32 * nb, scr, lane); continue; } r -= I_SQ;
            if (r < I_KV) { const int kb = r / 64, nb = r % 64; transpose_item(w_xkv, 2 * D, Wxkv_t, D, 64 * kb, 32 * nb, 32 * nb, scr, lane); continue; } r -= I_KV;
            if (r < I_GU) { const int kb = r / 176, nb = r % 176; const int n0 = 32 * nb; const int isu = n0 >= DFF ? 1 : 0, nn = n0 - isu * DFF;
                            transpose_item(w_gate_up, 2 * DFF, Wgu_t, D, 64 * kb, n0, 256 * (nn >> 7) + 128 * isu + (nn & 127), scr, lane); continue; } r -= I_GU;
            if (r < I_DN) { const int kb = r / 32, nb = r % 32; transpose_item(w_down, D, Wdn_t, DFF, 64 * kb, 32 * nb, 32 * nb, scr, lane); continue; } r -= I_DN;
            if (r < I_C1) { const int kb = r / 8, nb = r % 8; transpose_item(cmp_w1_k, 256, Wc1_t, 2048, 64 * kb, 32 * nb, 32 * nb, scr, lane); continue; } r -= I_C1;
            { const int kb = r / 8, nb = r % 8; transpose_item(cmp_w1_v, 256, Wc1_t + 256 * 2048, 2048, 64 * kb, 32 * nb, 32 * nb, scr, lane); }
        }
        for (long i = gtid; i < (long)(NPROJ_PAD - NPROJ) * D / 8; i += NGT) ((GAS v4u*)(Win_t + (size_t)NPROJ * D))[i] = (v4u){0u, 0u, 0u, 0u};
        for (int it = gw; it < 256; it += NGW) {
            const int kv = it >> 7, nc = (it >> 5) & 3, kc = it & 31; const float* pos = kv ? cmp_pos_v : cmp_pos_k; const float* w1 = kv ? cmp_w1_v : cmp_w1_k;
            float a = 0.f;
#pragma unroll 8
            for (int kk = 0; kk < 64; ++kk) a += pos[kc * 64 + kk] * w1[(size_t)(kc * 64 + kk) * 256 + nc * 64 + lane];
            atomicAdd(&CB1[kv * 256 + nc * 64 + lane], a);
        }
        for (int m = gw; m < T; m += NGW) rms_row_to_bf16(x_in + (size_t)m * D, g_mix_pre, H + (size_t)m * D, lane);
        for (int m = gw; m < BATCH * MEMT; m += NGW) rms_row_to_bf16(mem_in + (size_t)m * D, g_mem, MEMN + (size_t)m * D, lane);
    }
    SEAM(0);

    if (IN(1)) {
        { pg8::Gemm g{H, Win_t, D, D, D}; pg8::GridOrder S; S.init(T, NPROJ_PAD, D, D, G, bx); pg8::EpiBf16 E{PROJ, NPROJ_PAD, 1.0f};
          pg8::gemm_phase<pg8::EpiBf16, pg8::GridOrder, true, true>(lds, g, S, E); }
        { pg8::Gemm g{MEMN, Wxkv_t, D, D, D}; pg8::GridOrder S; S.init(BATCH * MEMT, D, D, D, G, bx); pg8::EpiBf16 E{MEMK, D, 1.0f};
          pg8::gemm_phase<pg8::EpiBf16, pg8::GridOrder, true, true>(lds, g, S, E); }
        { pg8::Gemm g{Wxkv_t + (size_t)D * D, MEMN, D, D, D}; pg8::GridOrder S; S.init(D, BATCH * MEMT, D, D, G, bx); pg8::EpiBf16 E{VT, BATCH * MEMT, 1.0f};
          pg8::gemm_phase<pg8::EpiBf16, pg8::GridOrder, true, true>(lds, g, S, E); }
    }
    SEAM(1);

    if (IN(2)) {
        for (int bh = gw; bh < 32; bh += NGW) {
            const int b = bh >> 2, h = bh & 3; float m = 0.f; const float gbi = gate_bias[h], gbf = gate_bias[4 + h];
            if (lane == 0) MST[bh * 65] = 0.f;
            for (int k = 0; k < 64; ++k) {
                const size_t t = (size_t)b * SEQ + 64 * k + lane;
                const float ip = bf2f(PROJ[t * NPROJ_PAD + C_MI + h]) + gbi, fp = bf2f(PROJ[t * NPROJ_PAD + C_MF + h]) + gbf;
                const float lf = fminf(fp, 0.f) - log1pf(__expf(-fabsf(fp)));
                float bs = lf;
#pragma unroll
                for (int o = 1; o < 64; o <<= 1) { const float v = __shfl_up(bs, o); if (lane >= o) bs += v; }
                const float gg = ip - bs; float pmx = gg;
#pragma unroll
                for (int o = 1; o < 64; o <<= 1) { const float v = __shfl_up(pmx, o); if (lane >= o) pmx = fmaxf(pmx, v); }
                Bc[t * 4 + h] = bs; Gc[t * 4 + h] = gg; PM[t * 4 + h] = pmx;
                const float bL = __shfl(bs, 63), gmax = __shfl(pmx, 63);
                const float mn = fmaxf(bL + m, bL + gmax);
                if (lane == 0) { DEC[bh * 64 + k] = __expf(bL + m - mn); MST[bh * 65 + k + 1] = mn; }
                m = mn;
            }
        }
        for (long i = gtid; i < (long)T * 64; i += NGT) {
            const long t = i >> 6; const int c0 = (int)(i & 63) * 8, tt = (int)(t & (SEQ - 1));
            float a[8];
#pragma unroll
            for (int e = 0; e < 8; ++e) a[e] = conv_b[c0 + e];
#pragma unroll
            for (int j = 0; j < 4; ++j) { if (tt - 3 + j >= 0) { const v4u u = *(const GAS v4u*)(PROJ + (size_t)(t - 3 + j) * NPROJ_PAD + C_MQ + c0); const float* cw = conv_w + j * 512 + c0;
                a[0] += cw[0] * bflo(u.x); a[1] += cw[1] * bfhi(u.x); a[2] += cw[2] * bflo(u.y); a[3] += cw[3] * bfhi(u.y);
                a[4] += cw[4] * bflo(u.z); a[5] += cw[5] * bfhi(u.z); a[6] += cw[6] * bflo(u.w); a[7] += cw[7] * bfhi(u.w); } }
#pragma unroll
            for (int e = 0; e < 8; ++e) a[e] = a[e] * sigmoid_f(a[e]);
            v4u o; o.x = pk2(a[0], a[1]); o.y = pk2(a[2], a[3]); o.z = pk2(a[4], a[5]); o.w = pk2(a[6], a[7]);
            *(GAS v4u*)(MQK + (size_t)t * 512 + c0) = o;
        }
        for (long i = gtid; i < (long)2 * BATCH * 2 * SEQ * 8; i += NGT) {
            const int ch = (int)(i & 7); const long r = i >> 3; const int t = (int)(r & (SEQ - 1)); const int hkv = (int)((r >> 12) & 1), b = (int)((r >> 13) & 7), kv = (int)(r >> 16);
            *(GAS v4u*)(CKV + (size_t)r * 64 + ch * 8) = *(const GAS v4u*)(PROJ + ((size_t)b * SEQ + t) * NPROJ_PAD + C_KC + kv * 128 + hkv * 64 + ch * 8);
        }
    }
    SEAM(2);

    if (IN(3)) {
        { pg8::Gemm g{CKV, Wc1_t, 1024, 2048, 2048}; CmpOrder S{G, bx}; pg8::EpiSiluBias E{HID, 256, CB1};
          pg8::gemm_phase<pg8::EpiSiluBias, CmpOrder, true, true>(lds, g, S, E); }
        __syncthreads();
        LAS float* kwL = (LAS float*)lds; LAS float* vL = kwL + 64 * 64;
        for (int it = vcu; it < 2048; it += G) {
            const int bh = it >> 6, k = it & 63, b = bh >> 2, h = bh & 3; const size_t t0 = (size_t)b * SEQ + 64 * k;
            const float mnext = MST[bh * 65 + k + 1], bL = Bc[(t0 + 63) * 4 + h];
            for (int idx = tid; idx < 64 * 64; idx += 512) { const int s = idx >> 6, d = idx & 63;
                kwL[idx] = bf2f(MQK[(t0 + s) * 512 + 256 + h * 64 + d]) * 0.125f * __expf(bL + Gc[(t0 + s) * 4 + h] - mnext); }
            for (int idx = tid; idx < 64 * 128; idx += 512) { const int s = idx >> 7, vv = idx & 127; vL[idx] = bf2f(PROJ[(t0 + s) * NPROJ_PAD + C_MV + h * 128 + vv]); }
            __syncthreads();
            { const int d = tid >> 3, vg = tid & 7; f32x4 a[4] = {{0.f, 0.f, 0.f, 0.f}, {0.f, 0.f, 0.f, 0.f}, {0.f, 0.f, 0.f, 0.f}, {0.f, 0.f, 0.f, 0.f}};
              for (int s = 0; s < 64; ++s) { const float kwv = kwL[s * 64 + d]; const LAS f32x4* vp = (const LAS f32x4*)(vL + s * 128 + vg * 16);
#pragma unroll
                  for (int q = 0; q < 4; ++q) a[q] += vp[q] * kwv; }
              GAS f32x4* op = (GAS f32x4*)(CU + ((size_t)it * 64 + d) * 128 + vg * 16);
#pragma unroll
              for (int q = 0; q < 4; ++q) op[q] = a[q];
              if (tid < 64) { float un = 0.f; for (int s = 0; s < 64; ++s) un += kwL[s * 64 + tid]; NU[(size_t)it * 64 + tid] = un; } }
            __syncthreads();
        }
    }
    SEAM(3);

    if (IN(4)) {
        for (long i = gtid; i < (long)2 * 4096 * 64; i += NGT) {
            const int c = (int)(i & 63); const long r = i >> 6; const int kv = (int)(r >> 12); const float* w2 = kv ? cmp_w2_v : cmp_w2_k; const bf16* hp = HID + (size_t)r * 256;
            float a = 0.f;
#pragma unroll 8
            for (int n = 0; n < 256; ++n) a += bf2f(hp[n]) * w2[n * 64 + c];
            KCMP[i] = a;
        }
        for (long i = gtid; i < (long)32 * 8192 + 32 * 64; i += NGT) {
            if (i < (long)32 * 8192) { const int bh = (int)(i >> 13), e = (int)(i & 8191); float c = 0.f;
                for (int k = 0; k < 64; ++k) { float* p = CU + ((size_t)(bh * 64 + k)) * 8192 + e; const float u = *p; *p = c; c = DEC[bh * 64 + k] * c + u; } }
            else { const long j = i - (long)32 * 8192; const int bh = (int)(j >> 6), e = (int)(j & 63); float c = 0.f;
                for (int k = 0; k < 64; ++k) { float* p = NU + ((size_t)(bh * 64 + k)) * 64 + e; const float u = *p; *p = c; c = DEC[bh * 64 + k] * c + u; } }
        }
    }
    SEAM(4);

    if (IN(5)) {
        {
            LAS float* qL = (LAS float*)lds; LAS float* kL = qL + 64 * 65; LAS float* vL = kL + 64 * 65; LAS float* CL = vL + 64 * 128; LAS float* SL = CL + 64 * 128;
            LAS float* nL = SL + 64 * 65; LAS float* bLs = nL + 64; LAS float* GLs = bLs + 64; LAS float* mtL = GLs + 64; LAS float* aL = mtL + 64;
            for (int it = vcu; it < 2048; it += G) {
                const int bh = it >> 6, k = it & 63, b = bh >> 2, h = bh & 3; const size_t t0 = (size_t)b * SEQ + 64 * k;
                for (int idx = tid; idx < 64 * 64; idx += 512) { const int s = idx >> 6, d = idx & 63;
                    qL[s * 65 + d] = bf2f(MQK[(t0 + s) * 512 + h * 64 + d]); kL[s * 65 + d] = bf2f(MQK[(t0 + s) * 512 + 256 + h * 64 + d]) * 0.125f; }
                for (int idx = tid; idx < 64 * 128; idx += 512) { const int s = idx >> 7, vv = idx & 127; vL[idx] = bf2f(PROJ[(t0 + s) * NPROJ_PAD + C_MV + h * 128 + vv]); CL[idx] = CU[(size_t)it * 8192 + idx]; }
                if (tid < 64) { const float bt = Bc[(t0 + tid) * 4 + h], pm = PM[(t0 + tid) * 4 + h], mk = MST[bh * 65 + k]; const float mt = fmaxf(bt + mk, bt + pm);
                    mtL[tid] = mt; aL[tid] = __expf(bt + mk - mt); bLs[tid] = bt; GLs[tid] = Gc[(t0 + tid) * 4 + h]; nL[tid] = NU[(size_t)it * 64 + tid]; }
                __syncthreads();
                { const int t = tid >> 3, sg = tid & 7; float dots[8];
#pragma unroll
                  for (int j = 0; j < 8; ++j) dots[j] = 0.f;
                  for (int d = 0; d < 64; ++d) { const float qv = qL[t * 65 + d];
#pragma unroll
                      for (int j = 0; j < 8; ++j) dots[j] += qv * kL[(sg * 8 + j) * 65 + d]; }
                  const float bt = bLs[t], mt = mtL[t];
#pragma unroll
                  for (int j = 0; j < 8; ++j) { const int s = sg * 8 + j; SL[t * 65 + s] = (s <= t) ? dots[j] * __expf(bt + GLs[s] - mt) : 0.f; } }
                __syncthreads();
                { const int t = tid >> 3, vg = tid & 7; f32x4 num[4] = {{0.f, 0.f, 0.f, 0.f}, {0.f, 0.f, 0.f, 0.f}, {0.f, 0.f, 0.f, 0.f}, {0.f, 0.f, 0.f, 0.f}}; float den = 0.f;
                  for (int s = 0; s < 64; ++s) { const float sv = SL[t * 65 + s]; den += sv; const LAS f32x4* vp = (const LAS f32x4*)(vL + s * 128 + vg * 16);
#pragma unroll
                      for (int q = 0; q < 4; ++q) num[q] += vp[q] * sv; }
                  const float a = aL[t]; float qn = 0.f;
                  for (int d = 0; d < 64; ++d) { const float qa = qL[t * 65 + d] * a; qn += qa * nL[d]; const LAS f32x4* cp = (const LAS f32x4*)(CL + d * 128 + vg * 16);
#pragma unroll
                      for (int q = 0; q < 4; ++q) num[q] += cp[q] * qa; }
                  den += qn;
                  const float dn = fmaxf(fabsf(den), __expf(-mtL[t])), inv = 1.0f / dn; float ss = 0.f;
#pragma unroll
                  for (int q = 0; q < 4; ++q) { num[q] = num[q] * inv; ss += (num[q].x * num[q].x + num[q].y * num[q].y) + (num[q].z * num[q].z + num[q].w * num[q].w); }
                  ss += __shfl_xor(ss, 1); ss += __shfl_xor(ss, 2); ss += __shfl_xor(ss, 4);
                  const float rstd = 1.0f / sqrtf(ss * (1.0f / 128.0f) + EPS);
                  const int c0 = h * 128 + vg * 16; const bf16* mo = PROJ + (t0 + t) * NPROJ_PAD + C_MO + c0; const float* gn = mlstm_norm + c0;
                  unsigned w[8];
#pragma unroll
                  for (int q = 0; q < 4; ++q) { const float y0 = sigmoid_f(bf2f(mo[q * 4 + 0])) * (num[q].x * rstd * gn[q * 4 + 0]), y1 = sigmoid_f(bf2f(mo[q * 4 + 1])) * (num[q].y * rstd * gn[q * 4 + 1]);
                      const float y2 = sigmoid_f(bf2f(mo[q * 4 + 2])) * (num[q].z * rstd * gn[q * 4 + 2]), y3 = sigmoid_f(bf2f(mo[q * 4 + 3])) * (num[q].w * rstd * gn[q * 4 + 3]);
                      w[q * 2] = pk2(y0, y1); w[q * 2 + 1] = pk2(y2, y3); }
                  GAS v4u* op = (GAS v4u*)(YMIX + (t0 + t) * D + 512 + c0); op[0] = (v4u){w[0], w[1], w[2], w[3]}; op[1] = (v4u){w[4], w[5], w[6], w[7]}; }
                __syncthreads();
            }
        }
        {
            LAS float* biasT = (LAS float*)lds;
            LAS f32x4* qs = (LAS f32x4*)(lds + 8192 + wave * 5120);
            LAS f32x4* ps = qs + 64;
            for (int idx = tid; idx < 8 * 132; idx += 512) { const int hh = idx / 132, d = idx % 132; biasT[idx] = rel_bias[hh * 32 + kBucket[d < 128 ? d : 128]]; }
            __syncthreads();
            for (int item = gw; item < BATCH * 2 * SEQ; item += NGW) {
                const int t = item & (SEQ - 1), hkv = (item >> 12) & 1, b = item >> 13;
                const size_t row = (size_t)b * SEQ + t; const bf16* prow = PROJ + row * NPROJ_PAD;
                const LAS float* bT = biasT + (hkv * 4) * 132;
                { f32x4 qv; qv.x = bf2f(prow[(hkv * 4 + 0) * 64 + lane]) * 0.125f; qv.y = bf2f(prow[(hkv * 4 + 1) * 64 + lane]) * 0.125f;
                  qv.z = bf2f(prow[(hkv * 4 + 2) * 64 + lane]) * 0.125f; qv.w = bf2f(prow[(hkv * 4 + 3) * 64 + lane]) * 0.125f; qs[lane] = qv; }
                LDS_WAIT();
                int ncv = (t >= 31) ? ((t - 31) >> 4) + 1 : 0; if (ncv > 255) ncv = 255;
                const float* kc = KCMP + ((size_t)(0 * BATCH + b) * 2 + hkv) * 256 * 64; const float* vc = KCMP + ((size_t)(1 * BATCH + b) * 2 + hkv) * 256 * 64;
                f32x4 sc[4];
#pragma unroll
                for (int r = 0; r < 4; ++r) { const int c = lane + 64 * r; const bool valid = c < ncv; const int cc = c < 255 ? c : 254; const GAS f32x4* kr = (const GAS f32x4*)(kc + (size_t)cc * 64);
                    f32x4 dsum = {0.f, 0.f, 0.f, 0.f};
#pragma unroll 4
                    for (int d4 = 0; d4 < 16; ++d4) { const f32x4 kk = kr[d4]; dsum += qs[d4 * 4 + 0] * kk.x; dsum += qs[d4 * 4 + 1] * kk.y; dsum += qs[d4 * 4 + 2] * kk.z; dsum += qs[d4 * 4 + 3] * kk.w; }
                    int dd = t - (16 * cc + 31); dd = dd < 0 ? 0 : (dd > 128 ? 128 : dd);
                    dsum.x += bT[dd]; dsum.y += bT[132 + dd]; dsum.z += bT[264 + dd]; dsum.w += bT[396 + dd];
                    sc[r] = valid ? dsum : (f32x4){-1e30f, -1e30f, -1e30f, -1e30f}; }
                f32x4 mx; mx.x = wave_max(fmaxf(fmaxf(sc[0].x, sc[1].x), fmaxf(sc[2].x, sc[3].x))); mx.y = wave_max(fmaxf(fmaxf(sc[0].y, sc[1].y), fmaxf(sc[2].y, sc[3].y)));
                mx.z = wave_max(fmaxf(fmaxf(sc[0].z, sc[1].z), fmaxf(sc[2].z, sc[3].z))); mx.w = wave_max(fmaxf(fmaxf(sc[0].w, sc[1].w), fmaxf(sc[2].w, sc[3].w)));
                f32x4 lsum = {0.f, 0.f, 0.f, 0.f};
#pragma unroll
                for (int r = 0; r < 4; ++r) { const bool valid = (lane + 64 * r) < ncv; f32x4 p; p.x = valid ? __expf(sc[r].x - mx.x) : 0.f; p.y = valid ? __expf(sc[r].y - mx.y) : 0.f;
                    p.z = valid ? __expf(sc[r].z - mx.z) : 0.f; p.w = valid ? __expf(sc[r].w - mx.w) : 0.f; sc[r] = p; lsum += p; }
                lsum.x = wave_sum(lsum.x); lsum.y = wave_sum(lsum.y); lsum.z = wave_sum(lsum.z); lsum.w = wave_sum(lsum.w);
                f32x4 linv; linv.x = ncv > 0 ? 1.0f / lsum.x : 0.f; linv.y = ncv > 0 ? 1.0f / lsum.y : 0.f; linv.z = ncv > 0 ? 1.0f / lsum.z : 0.f; linv.w = ncv > 0 ? 1.0f / lsum.w : 0.f;
#pragma unroll
                for (int r = 0; r < 4; ++r) ps[lane + 64 * r] = sc[r] * linv;
                LDS_WAIT();
                f32x4 oc = {0.f, 0.f, 0.f, 0.f};
                for (int c = 0; c < ncv; ++c) { const f32x4 pv = ps[c]; const float vv = vc[(size_t)c * 64 + lane]; oc += pv * vv; }
                float imp = 0.f;
                { const int c0 = 4 * lane - 1 < 0 ? 0 : 4 * lane - 1, c1 = 4 * lane + 3 > 254 ? 254 : 4 * lane + 3;
                  for (int c = c0; c <= c1; ++c) { const f32x4 pv = ps[c]; imp += (pv.x + pv.y) + (pv.z + pv.w); } }
                const int cur = t >> 6;
                const bool forced = (lane == 0) || (lane == cur) || (lane == cur - 1);
                const float score = forced ? 1.0e4f : (lane <= cur ? imp : -1.0f);
                int rank = 0;
#pragma unroll 4
                for (int i = 0; i < 64; ++i) { const float si = __int_as_float(__builtin_amdgcn_readlane(__float_as_int(score), i)); rank += ((si > score) || (si == score && i < lane)) ? 1 : 0; }
                unsigned long long sel = __ballot(rank < 16);
                sel &= (cur == 63) ? ~0ull : ((1ull << (cur + 1)) - 1ull);
                LDS_WAIT();
                f32x4 mS = {-1e30f, -1e30f, -1e30f, -1e30f}, lS = {0.f, 0.f, 0.f, 0.f}, oS = {0.f, 0.f, 0.f, 0.f};
                while (sel) {
                    const int j = __builtin_ctzll(sel); sel &= sel - 1ull;
                    const int kpos = 64 * j + lane; const bool valid = kpos <= t;
                    const GAS v4u* kr = (const GAS v4u*)(PROJ + ((size_t)b * SEQ + kpos) * NPROJ_PAD + C_KSL + 64 * hkv);
                    f32x4 dsum = {0.f, 0.f, 0.f, 0.f};
#pragma unroll
                    for (int c8 = 0; c8 < 8; ++c8) { const v4u kk = kr[c8];
                        dsum += qs[c8 * 8 + 0] * bflo(kk.x); dsum += qs[c8 * 8 + 1] * bfhi(kk.x); dsum += qs[c8 * 8 + 2] * bflo(kk.y); dsum += qs[c8 * 8 + 3] * bfhi(kk.y);
                        dsum += qs[c8 * 8 + 4] * bflo(kk.z); dsum += qs[c8 * 8 + 5] * bfhi(kk.z); dsum += qs[c8 * 8 + 6] * bflo(kk.w); dsum += qs[c8 * 8 + 7] * bfhi(kk.w); }
                    int dd = t - kpos; dd = dd < 0 ? 0 : (dd > 128 ? 128 : dd);
                    dsum.x += bT[dd]; dsum.y += bT[132 + dd]; dsum.z += bT[264 + dd]; dsum.w += bT[396 + dd];
                    if (!valid) dsum = (f32x4){-1e30f, -1e30f, -1e30f, -1e30f};
                    f32x4 mn; mn.x = fmaxf(mS.x, wave_max(dsum.x)); mn.y = fmaxf(mS.y, wave_max(dsum.y)); mn.z = fmaxf(mS.z, wave_max(dsum.z)); mn.w = fmaxf(mS.w, wave_max(dsum.w));
                    f32x4 scl; scl.x = __expf(mS.x - mn.x); scl.y = __expf(mS.y - mn.y); scl.z = __expf(mS.z - mn.z); scl.w = __expf(mS.w - mn.w);
                    f32x4 p; p.x = valid ? __expf(dsum.x - mn.x) : 0.f; p.y = valid ? __expf(dsum.y - mn.y) : 0.f; p.z = valid ? __expf(dsum.z - mn.z) : 0.f; p.w = valid ? __expf(dsum.w - mn.w) : 0.f;
                    lS.x = lS.x * scl.x + wave_sum(p.x); lS.y = lS.y * scl.y + wave_sum(p.y); lS.z = lS.z * scl.z + wave_sum(p.z); lS.w = lS.w * scl.w + wave_sum(p.w);
                    oS = oS * scl; mS = mn;
                    ps[lane] = p; LDS_WAIT();
                    const int khi = (t - 64 * j) < 63 ? (t - 64 * j) : 63;
                    const bf16* vb = PROJ + ((size_t)b * SEQ + 64 * j) * NPROJ_PAD + C_VSL + 64 * hkv + lane;
                    for (int k = 0; k <= khi; ++k) { const f32x4 pv = ps[k]; const float vv = bf2f(vb[(size_t)k * NPROJ_PAD]); oS += pv * vv; }
                    LDS_WAIT();
                }
                f32x4 mW = {-1e30f, -1e30f, -1e30f, -1e30f}, lW = {0.f, 0.f, 0.f, 0.f}, oW = {0.f, 0.f, 0.f, 0.f};
                const int wlo = t - 511 < 0 ? 0 : t - 511;
                for (int r = 0; r < 9; ++r) {
                    const int base = (t & ~63) - 512 + 64 * r;
                    if (base + 63 < wlo || base > t) continue;
                    const int kpos = base + lane; const bool valid = (kpos >= wlo) && (kpos <= t); const int kp = kpos < 0 ? 0 : kpos;
                    const GAS v4u* kr = (const GAS v4u*)(PROJ + ((size_t)b * SEQ + kp) * NPROJ_PAD + C_KWN + 64 * hkv);
                    f32x4 dsum = {0.f, 0.f, 0.f, 0.f};
#pragma unroll
                    for (int c8 = 0; c8 < 8; ++c8) { const v4u kk = kr[c8];
                        dsum += qs[c8 * 8 + 0] * bflo(kk.x); dsum += qs[c8 * 8 + 1] * bfhi(kk.x); dsum += qs[c8 * 8 + 2] * bflo(kk.y); dsum += qs[c8 * 8 + 3] * bfhi(kk.y);
                        dsum += qs[c8 * 8 + 4] * bflo(kk.z); dsum += qs[c8 * 8 + 5] * bfhi(kk.z); dsum += qs[c8 * 8 + 6] * bflo(kk.w); dsum += qs[c8 * 8 + 7] * bfhi(kk.w); }
                    int dd = t - kpos; dd = dd < 0 ? 0 : (dd > 128 ? 128 : dd);
                    dsum.x += bT[dd]; dsum.y += bT[132 + dd]; dsum.z += bT[264 + dd]; dsum.w += bT[396 + dd];
                    if (!valid) dsum = (f32x4){-1e30f, -1e30f, -1e30f, -1e30f};
                    f32x4 mn; mn.x = fmaxf(mW.x, wave_max(dsum.x)); mn.y = fmaxf(mW.y, wave_max(dsum.y)); mn.z = fmaxf(mW.z, wave_max(dsum.z)); mn.w = fmaxf(mW.w, wave_max(dsum.w));
                    f32x4 scl; scl.x = __expf(mW.x - mn.x); scl.y = __expf(mW.y - mn.y); scl.z = __expf(mW.z - mn.z); scl.w = __expf(mW.w - mn.w);
                    f32x4 p; p.x = valid ? __expf(dsum.x - mn.x) : 0.f; p.y = valid ? __expf(dsum.y - mn.y) : 0.f; p.z = valid ? __expf(dsum.z - mn.z) : 0.f; p.w = valid ? __expf(dsum.w - mn.w) : 0.f;
                    lW.x = lW.x * scl.x + wave_sum(p.x); lW.y = lW.y * scl.y + wave_sum(p.y); lW.z = lW.z * scl.z + wave_sum(p.z); lW.w = lW.w * scl.w + wave_sum(p.w);
                    oW = oW * scl; mW = mn;
                    ps[lane] = p; LDS_WAIT();
                    const int klo = wlo - base < 0 ? 0 : wlo - base, khi = (t - base) < 63 ? (t - base) : 63;
                    const long vrow0 = (long)b * SEQ + base;
                    for (int k = klo; k <= khi; ++k) { const f32x4 pv = ps[k]; const float vv = bf2f(PROJ[(size_t)(vrow0 + k) * NPROJ_PAD + C_VWN + 64 * hkv + lane]); oW += pv * vv; }
                    LDS_WAIT();
                }
                const bf16* gp = prow + C_GT + (hkv * 4) * 3;
                float res[4];
#pragma unroll
                for (int g = 0; g < 4; ++g) { const float gc = sigmoid_f(bf2f(gp[g * 3 + 0])), gs = sigmoid_f(bf2f(gp[g * 3 + 1])), gwn = sigmoid_f(bf2f(gp[g * 3 + 2]));
                    res[g] = gc * oc[g] + gs * (oS[g] / lS[g]) + gwn * (oW[g] / lW[g]); }
#pragma unroll
                for (int g = 0; g < 4; ++g) YMIX[row * D + (hkv * 4 + g) * 64 + lane] = (bf16)f2bf(res[g]);
            }
            __syncthreads();
        }
    }
    SEAM(5);

    if (IN(6)) { pg8::Gemm g{YMIX, Wout_t, D, D, D}; pg8::GridOrder S; S.init(T, D, D, D, G, bx); pg8::EpiF32 E{Y1, D};
        pg8::gemm_phase<pg8::EpiF32, pg8::GridOrder, true, true>(lds, g, S, E); }
    SEAM(6);
    if (IN(7)) { for (int m = gw; m < T; m += NGW) resnorm_row(Y1 + (size_t)m * D, x_in + (size_t)m * D, g_mix_post, out_p + (size_t)m * D, g_x_pre, H + (size_t)m * D, lane); }
    SEAM(7);
    if (IN(8)) { pg8::Gemm g{H, Wxq_t, D, D, D}; pg8::GridOrder S; S.init(T, D, D, D, G, bx); pg8::EpiBf16 E{QX, D, 0.0625f};
        pg8::gemm_phase<pg8::EpiBf16, pg8::GridOrder, true, true>(lds, g, S, E); }
    SEAM(8);
    if (IN(9)) { pg8::Gemm g{QX, MEMK, D, D, 256}; XaSOrder S{G, bx}; pg8::EpiF32 E{Y1, D};
        pg8::gemm_phase<pg8::EpiF32, XaSOrder, true, true>(lds, g, S, E); }
    SEAM(9);
    if (IN(10)) {
        for (int m = gw; m < T; m += NGW) {
            const GAS f32x4* sr = (const GAS f32x4*)(Y1 + (size_t)m * D) + lane; GAS unsigned long long* o8 = (GAS unsigned long long*)(PB + (size_t)m * D) + lane;
#pragma unroll
            for (int h = 0; h < 4; ++h) { const f32x4 v = sr[64 * h]; const float mx = wave_max(fmaxf(fmaxf(v.x, v.y), fmaxf(v.z, v.w)));
                f32x4 p; p.x = __expf(v.x - mx); p.y = __expf(v.y - mx); p.z = __expf(v.z - mx); p.w = __expf(v.w - mx);
                const float inv = 1.0f / wave_sum((p.x + p.y) + (p.z + p.w));
                o8[64 * h] = (unsigned long long)pk2(p.x * inv, p.y * inv) | ((unsigned long long)pk2(p.z * inv, p.w * inv) << 32); }
        }
    }
    SEAM(10);
    if (IN(11)) { pg8::Gemm g{PB, VT, D, BATCH * MEMT, 256}; XaPVOrder S{G, bx}; pg8::EpiBf16 E{OX, D, 1.0f};
        pg8::gemm_phase<pg8::EpiBf16, XaPVOrder, true, true>(lds, g, S, E); }
    SEAM(11);
    if (IN(12)) { pg8::Gemm g{OX, Wxo_t, D, D, D}; pg8::GridOrder S; S.init(T, D, D, D, G, bx); pg8::EpiF32 E{Y1, D};
        pg8::gemm_phase<pg8::EpiF32, pg8::GridOrder, true, true>(lds, g, S, E); }
    SEAM(12);
    if (IN(13)) { for (int m = gw; m < T; m += NGW) resnorm_row(Y1 + (size_t)m * D, out_p + (size_t)m * D, g_x_post, out_p + (size_t)m * D, g_ffn_pre, H + (size_t)m * D, lane); }
    SEAM(13);
    if (IN(14)) { pg8::Gemm g{H, Wgu_t, D, D, D}; pg8::GridOrder S; S.init(T, 2 * DFF, D, D, G, bx); pg8::EpiSwiglu E{ACT, DFF};
        pg8::gemm_phase<pg8::EpiSwiglu, pg8::GridOrder, true, true>(lds, g, S, E); }
    SEAM(14);
    if (IN(15)) { pg8::Gemm g{ACT, Wdn_t, DFF, DFF, DFF}; pg8::GridOrder S; S.init(T, D, DFF, DFF, G, bx); pg8::EpiF32 E{Y2, D};
        pg8::gemm_phase<pg8::EpiF32, pg8::GridOrder, true, true>(lds, g, S, E); }
    SEAM(15);
    if (IN(16)) { for (int m = gw; m < T; m += NGW) resnorm_row(Y2 + (size_t)m * D, out_p + (size_t)m * D, g_ffn_post, out_p + (size_t)m * D, nullptr, nullptr, lane); }
#undef IN
#undef SEAM
}

extern "C" void kernel_launch(void* const* d_in, const int* in_sizes, int n_in, void* d_out, int out_size, void* d_ws, size_t ws_size, hipStream_t stream) {
    static int grid = 0;
    if (grid == 0) {
        if (n_in != 27 || in_sizes[0] != T * D || out_size != T * D || ws_size < WS_END) { fprintf(stderr, "kernel_launch: unexpected shapes (n_in %d, in0 %d, out %d, ws %zu); nothing launched\n", n_in, n_in > 0 ? in_sizes[0] : -1, out_size, ws_size); grid = -1; return; }
        int dev = 0, cus = 0, per_cu = 0;
        if (hipGetDevice(&dev) != hipSuccess || hipDeviceGetAttribute(&cus, hipDeviceAttributeMultiprocessorCount, dev) != hipSuccess) { grid = -1; return; }
        if (hipFuncSetAttribute((const void*)hymba_fwd, hipFuncAttributeMaxDynamicSharedMemorySize, LDS_BYTES) != hipSuccess) { fprintf(stderr, "kernel_launch: hipFuncSetAttribute failed\n"); grid = -1; return; }
        if (hipOccupancyMaxActiveBlocksPerMultiprocessor(&per_cu, (const void*)hymba_fwd, NWAVES * 64, LDS_BYTES) != hipSuccess || per_cu < 1) fprintf(stderr, "kernel_launch: occupancy query reports %d workgroups per CU\n", per_cu);
        (void)hipGetLastError();
        grid = cus;
    }
    if (grid < 0) return;
    if (hipMemsetAsync((char*)d_ws + WS_CTL, 0, CTL_ZERO_BYTES, stream) != hipSuccess) return;
    Args a{};
    for (int i = 0; i < 27; ++i) a.in[i] = (const float*)d_in[i];
    a.out = (float*)d_out; a.ws = (unsigned char*)d_ws;
#if MK_ONE_LAUNCH
    a.ph_lo = 0; a.ph_hi = NPHASE;
    hipLaunchKernelGGL(hymba_fwd, dim3(grid), dim3(NWAVES * 64), LDS_BYTES, stream, a);
#else
    for (int p = 0; p < NPHASE; ++p) { a.ph_lo = p; a.ph_hi = p + 1; hipLaunchKernelGGL(hymba_fwd, dim3(grid), dim3(NWAVES * 64), LDS_BYTES, stream, a); }
#endif
}
```

```cpp
#include <hip/hip_runtime.h>
#include <cstdio>
#include <cstdint>

#ifndef MK_ONE_LAUNCH
#define MK_ONE_LAUNCH 1
#endif

namespace pg8 {
#define PG8_LAS __attribute__((address_space(3)))
typedef unsigned short bf16_t;
typedef short bf16x8 __attribute__((ext_vector_type(8)));
typedef float f32x4 __attribute__((ext_vector_type(4)));
typedef unsigned u32x4 __attribute__((ext_vector_type(4)));
constexpr int BM = 256, BK = 64, HALF = 128, HTB = HALF * BK * 2, STAGE_BYTES = 8 * HTB, NXCD = 8, WGM = 8;

__host__ __device__ __forceinline__ int lds_byte(int r, int c) { const int st = (r >> 4) * 2 + (c >> 5), rr = r & 15, cc = c & 31, ob = rr * 64 + cc * 2; return st * 1024 + (ob ^ (((ob >> 9) & 1) << 5)); }
__host__ __device__ __forceinline__ void stage_rc(int b, int& R, int& C) { const int st = b / 1024, sb = b % 1024, swz = sb ^ (((sb >> 9) & 1) << 5); R = (st >> 1) * 16 + swz / 64; C = (st & 1) * 32 + (swz % 64) / 2; }
__host__ __device__ __forceinline__ int perm32(int rho) { const int n = rho >> 4, i = rho & 15; return 8 * (i >> 2) + 4 * n + (i & 3); }

struct Unit { int orow, ocol, bz; };
struct Gemm { const bf16_t* A; const bf16_t* Bt; int lda, ldb, K; };

struct GridOrder {
    int nM, nN, nwg, G, c, lda, ldb;
    __device__ void init(int M, int N, int lda_, int ldb_, int G_, int c_) { nM = M / BM; nN = N / BM; nwg = nM * nN; G = G_; c = c_; lda = lda_; ldb = ldb_; }
    __device__ bool next(int i, Unit& u) const {
        const long L = (long)i * G + c; if (L >= nwg) return false;
        int wgid = (int)L; { const int q = nwg / NXCD, r = nwg % NXCD, xcd = wgid % NXCD, off = wgid / NXCD; wgid = (xcd < r ? xcd * (q + 1) : r * (q + 1) + (xcd - r) * q) + off; }
        const int nig = WGM * nN, gid = wgid / nig, fm = gid * WGM, gsz = (nM - fm) < WGM ? (nM - fm) : WGM;
        const int pm = fm + ((wgid % nig) % gsz), pn = (wgid % nig) / gsz; u.bz = 0; u.orow = pm * BM; u.ocol = pn * BM; return true;
    }
    __device__ __forceinline__ long offA(const Unit& u) const { return (long)u.orow * lda; }
    __device__ __forceinline__ long offB(const Unit& u) const { return (long)u.ocol * ldb; }
};

__device__ __forceinline__ unsigned cvt_pk_bf16(float lo, float hi) { unsigned r; asm volatile("v_cvt_pk_bf16_f32 %0, %1, %2" : "=v"(r) : "v"(lo), "v"(hi)); return r; }
__device__ __forceinline__ float silu_f(float v) { return v / (1.0f + __expf(-v)); }

struct EpiBf16 {
    static constexpr bool PERM = true;
    bf16_t* O; int ldc; float scale;
    __device__ __forceinline__ void operator()(f32x4 (&acc)[2][2][4][2], const Unit& u, int wr, int wc, int fr, int fq) const {
        const int row0 = u.orow + wr * 64 + fr, col0 = u.ocol + wc * 32 + 8 * fq;
#pragma unroll
        for (int ai = 0; ai < 2; ++ai)
#pragma unroll
            for (int m = 0; m < 4; ++m) { bf16_t* rowp = O + (size_t)(row0 + ai * HALF + m * 16) * ldc + col0;
#pragma unroll
                for (int bj = 0; bj < 2; ++bj) { const f32x4 v0 = acc[ai][bj][m][0] * scale, v1 = acc[ai][bj][m][1] * scale;
                    u32x4 w; w.x = cvt_pk_bf16(v0[0], v0[1]); w.y = cvt_pk_bf16(v0[2], v0[3]); w.z = cvt_pk_bf16(v1[0], v1[1]); w.w = cvt_pk_bf16(v1[2], v1[3]);
                    *(u32x4*)(rowp + bj * HALF) = w; } }
    }
};
struct EpiF32 {
    static constexpr bool PERM = false;
    float* O; int ldc;
    __device__ __forceinline__ void operator()(f32x4 (&acc)[2][2][4][2], const Unit& u, int wr, int wc, int fr, int fq) const {
        const int row0 = u.orow + wr * 64 + fr, col0 = u.ocol + wc * 32 + 4 * fq;
#pragma unroll
        for (int ai = 0; ai < 2; ++ai)
#pragma unroll
            for (int m = 0; m < 4; ++m) { float* rowp = O + (size_t)(row0 + ai * HALF + m * 16) * ldc + col0;
#pragma unroll
                for (int bj = 0; bj < 2; ++bj)
#pragma unroll
                    for (int n = 0; n < 2; ++n) *(f32x4*)(rowp + bj * HALF + n * 16) = acc[ai][bj][m][n]; }
    }
};
struct EpiSiluBias {
    static constexpr bool PERM = true;
    bf16_t* O; int ldc; const float* bias;
    __device__ __forceinline__ void operator()(f32x4 (&acc)[2][2][4][2], const Unit& u, int wr, int wc, int fr, int fq) const {
        const int row0 = u.orow + wr * 64 + fr, col0 = u.ocol + wc * 32 + 8 * fq; const float* bp = bias + u.bz * 256 + wc * 32 + 8 * fq;
        f32x4 bv[2][2];
#pragma unroll
        for (int bj = 0; bj < 2; ++bj)
#pragma unroll
            for (int n = 0; n < 2; ++n) bv[bj][n] = *(const f32x4*)(bp + bj * HALF + 4 * n);
#pragma unroll
        for (int ai = 0; ai < 2; ++ai)
#pragma unroll
            for (int m = 0; m < 4; ++m) { bf16_t* rowp = O + (size_t)(row0 + ai * HALF + m * 16) * ldc + col0;
#pragma unroll
                for (int bj = 0; bj < 2; ++bj) { f32x4 v0 = acc[ai][bj][m][0] + bv[bj][0], v1 = acc[ai][bj][m][1] + bv[bj][1];
#pragma unroll
                    for (int i = 0; i < 4; ++i) { v0[i] = silu_f(v0[i]); v1[i] = silu_f(v1[i]); }
                    u32x4 w; w.x = cvt_pk_bf16(v0[0], v0[1]); w.y = cvt_pk_bf16(v0[2], v0[3]); w.z = cvt_pk_bf16(v1[0], v1[1]); w.w = cvt_pk_bf16(v1[2], v1[3]);
                    *(u32x4*)(rowp + bj * HALF) = w; } }
    }
};
struct EpiSwiglu {
    static constexpr bool PERM = true;
    bf16_t* O; int ldc;
    __device__ __forceinline__ void operator()(f32x4 (&acc)[2][2][4][2], const Unit& u, int wr, int wc, int fr, int fq) const {
        const int row0 = u.orow + wr * 64 + fr, col0 = (u.ocol >> 1) + wc * 32 + 8 * fq;
#pragma unroll
        for (int ai = 0; ai < 2; ++ai)
#pragma unroll
            for (int m = 0; m < 4; ++m) { bf16_t* rowp = O + (size_t)(row0 + ai * HALF + m * 16) * ldc + col0;
                f32x4 v0, v1;
#pragma unroll
                for (int i = 0; i < 4; ++i) { v0[i] = silu_f(acc[ai][0][m][0][i]) * acc[ai][1][m][0][i]; v1[i] = silu_f(acc[ai][0][m][1][i]) * acc[ai][1][m][1][i]; }
                u32x4 w; w.x = cvt_pk_bf16(v0[0], v0[1]); w.y = cvt_pk_bf16(v0[2], v0[3]); w.z = cvt_pk_bf16(v1[0], v1[1]); w.w = cvt_pk_bf16(v1[2], v1[3]);
                *(u32x4*)rowp = w; }
    }
};
template <class Epi, class Sched, bool ALIGN_EPI, bool SP2>
__device__ __forceinline__ void gemm_phase(PG8_LAS unsigned char* lds, const Gemm g, const Sched& S, const Epi& E) {
    int tid_ = threadIdx.x; asm volatile("" : "+v"(tid_));
    const int tid = tid_, wid = __builtin_amdgcn_readfirstlane(tid >> 6), lane = tid & 63, wr = wid >> 2, wc = wid & 3, fr = lane & 15, fq = lane >> 4;
    const int K = g.K, nt = K / BK;
    unsigned voffA[2], voffB[2];
#pragma unroll
    for (int i = 0; i < 2; ++i) { int R, C; stage_rc(tid * 16 + i * 8192, R, C); const int Rb = Epi::PERM ? ((R & ~31) + perm32(R & 31)) : R;
        voffA[i] = (unsigned)(R * g.lda + C) * 2u; voffB[i] = (unsigned)(Rb * g.ldb + C) * 2u; }
    const size_t kstep = (size_t)(BK * 2);
    const size_t hstepA = (size_t)HALF * g.lda * 2, hstepB = (size_t)HALF * g.ldb * 2;
    const unsigned ldsw = (unsigned)wid * 1024u;
    const int aoff = lds_byte(wr * 64 + fr, fq * 8), boff = lds_byte(wc * 32 + fr, fq * 8);
#define PG8_SA(b, h) (((b) * 2 + (h)) * HTB)
#define PG8_SB(b, h) ((4 + (b) * 2 + (h)) * HTB)
#define PG8_STAGE(bufoff, gbase, voff) do { _Pragma("unroll") for (int _i = 0; _i < 2; ++_i) \
        __builtin_amdgcn_global_load_lds((const unsigned*)((const char*)(gbase) + (voff)[_i]), (PG8_LAS unsigned*)(lds + (bufoff) + ldsw + _i * 8192), 16, 0, 0); } while (0)
#define PG8_LDA(dst, b, h) do { _Pragma("unroll") for (int m = 0; m < 4; ++m) _Pragma("unroll") for (int k = 0; k < 2; ++k) dst[m][k] = *(const PG8_LAS bf16x8*)(lds + PG8_SA(b, h) + aoff + m * 2048 + k * 1024); } while (0)
#define PG8_LDB(dst, b, h) do { _Pragma("unroll") for (int n = 0; n < 2; ++n) _Pragma("unroll") for (int k = 0; k < 2; ++k) dst[n][k] = *(const PG8_LAS bf16x8*)(lds + PG8_SB(b, h) + boff + n * 2048 + k * 1024); } while (0)
#define PG8_MMA(ai, bj, At, Bt) do { __builtin_amdgcn_s_setprio(1); _Pragma("unroll") for (int m = 0; m < 4; ++m) _Pragma("unroll") for (int n = 0; n < 2; ++n) _Pragma("unroll") for (int k = 0; k < 2; ++k) \
        acc[ai][bj][m][n] = __builtin_amdgcn_mfma_f32_16x16x32_bf16(Bt[n][k], At[m][k], acc[ai][bj][m][n], 0, 0, 0); __builtin_amdgcn_s_setprio(0); } while (0)
#define PG8_WAIT_V(n) asm volatile("s_waitcnt vmcnt(" #n ")" ::: "memory")
#define PG8_WAIT_L(n) asm volatile("s_waitcnt lgkmcnt(" #n ")" ::: "memory")
#define PG8_BAR __builtin_amdgcn_s_barrier()
#define PG8_SCHED __builtin_amdgcn_sched_barrier(0)
    Unit cur, nxt; int ui = 0;
    if (!S.next(0, cur)) return;
    f32x4 acc[2][2][4][2];
#pragma unroll
    for (int a = 0; a < 2; ++a)
#pragma unroll
        for (int b = 0; b < 2; ++b)
#pragma unroll
            for (int m = 0; m < 4; ++m)
#pragma unroll
                for (int n = 0; n < 2; ++n) acc[a][b][m][n] = (f32x4){0.f, 0.f, 0.f, 0.f};
    bf16x8 At[4][2], B0[2][2], B1[2][2];
    const char* cA = (const char*)g.A + (size_t)S.offA(cur) * 2; const char* cB = (const char*)g.Bt + (size_t)S.offB(cur) * 2;
    if constexpr (SP2) {
        PG8_STAGE(PG8_SB(0, 0), cB, voffB); PG8_STAGE(PG8_SB(0, 1), cB + hstepB, voffB); PG8_STAGE(PG8_SA(0, 0), cA, voffA); PG8_STAGE(PG8_SA(0, 1), cA + hstepA, voffA);
        if (wr == 1) PG8_BAR;
        PG8_WAIT_V(2); PG8_BAR;
        PG8_STAGE(PG8_SB(1, 0), cB + kstep, voffB); PG8_STAGE(PG8_SA(1, 0), cA + kstep, voffA); PG8_STAGE(PG8_SB(1, 1), cB + hstepB + kstep, voffB);
        PG8_WAIT_V(6); PG8_BAR;
    } else {
        PG8_STAGE(PG8_SB(0, 0), cB, voffB); PG8_STAGE(PG8_SA(0, 0), cA, voffA); PG8_STAGE(PG8_SB(0, 1), cB + hstepB, voffB); PG8_STAGE(PG8_SA(0, 1), cA + hstepA, voffA);
        if (wr == 1) PG8_BAR;
        PG8_WAIT_V(4); PG8_BAR;
        PG8_STAGE(PG8_SB(1, 0), cB + kstep, voffB); PG8_STAGE(PG8_SA(1, 0), cA + kstep, voffA); PG8_STAGE(PG8_SB(1, 1), cB + hstepB + kstep, voffB);
        PG8_WAIT_V(6); PG8_BAR;
    }
    for (;;) {
        const bool has_next = S.next(ui + 1, nxt);
        const char* nA = has_next ? (const char*)g.A + (size_t)S.offA(nxt) * 2 : cA; const char* nB = has_next ? (const char*)g.Bt + (size_t)S.offB(nxt) * 2 : cB;
#pragma unroll 1
        for (int t = 0; t < nt; t += 2) {
            const bool last = (t == nt - 2);
            const char* a1 = cA + (size_t)(t + 1) * kstep;
            const char* a2 = last ? nA : cA + (size_t)(t + 2) * kstep; const char* b2 = last ? nB : cB + (size_t)(t + 2) * kstep;
            const char* a3 = a2 + kstep; const char* b3 = b2 + kstep;
            if constexpr (SP2) {
            PG8_LDB(B0, 0, 0); PG8_LDB(B1, 0, 1); PG8_SCHED; PG8_LDA(At, 0, 0); PG8_STAGE(PG8_SA(1, 1), a1 + hstepA, voffA);
            PG8_WAIT_V(8); PG8_WAIT_L(0); PG8_BAR; PG8_MMA(0, 0, At, B0); PG8_MMA(0, 1, At, B1); PG8_BAR; PG8_SCHED;
            PG8_LDA(At, 0, 1); PG8_STAGE(PG8_SB(0, 0), b2, voffB); PG8_STAGE(PG8_SB(0, 1), b2 + hstepB, voffB); PG8_STAGE(PG8_SA(0, 0), a2, voffA);
            PG8_WAIT_V(8); PG8_WAIT_L(0); PG8_BAR; PG8_MMA(1, 0, At, B0); PG8_MMA(1, 1, At, B1); PG8_BAR; PG8_SCHED;
            PG8_LDB(B0, 1, 0); PG8_LDB(B1, 1, 1); PG8_SCHED; PG8_LDA(At, 1, 0); PG8_STAGE(PG8_SA(0, 1), a2 + hstepA, voffA);
            PG8_WAIT_V(8); PG8_WAIT_L(0); PG8_BAR; PG8_MMA(0, 0, At, B0); PG8_MMA(0, 1, At, B1); PG8_BAR; PG8_SCHED;
            PG8_LDA(At, 1, 1); PG8_STAGE(PG8_SB(1, 0), b3, voffB); PG8_STAGE(PG8_SB(1, 1), b3 + hstepB, voffB); PG8_STAGE(PG8_SA(1, 0), a3, voffA);
            PG8_WAIT_V(8); PG8_WAIT_L(0); PG8_BAR; PG8_MMA(1, 0, At, B0); PG8_MMA(1, 1, At, B1); PG8_BAR; PG8_SCHED;
            } else {
            PG8_LDB(B0, 0, 0); PG8_SCHED; PG8_LDA(At, 0, 0); PG8_STAGE(PG8_SA(1, 1), a1 + hstepA, voffA);
            PG8_WAIT_L(8); PG8_BAR; PG8_WAIT_L(0); PG8_MMA(0, 0, At, B0); PG8_BAR; PG8_SCHED;
            PG8_LDB(B1, 0, 1); PG8_STAGE(PG8_SB(0, 0), b2, voffB);
            PG8_BAR; PG8_WAIT_L(0); PG8_MMA(0, 1, At, B1); PG8_BAR;
            PG8_LDA(At, 0, 1); PG8_STAGE(PG8_SA(0, 0), a2, voffA);
            PG8_BAR; PG8_WAIT_L(0); PG8_MMA(1, 0, At, B0); PG8_BAR; PG8_SCHED;
            PG8_STAGE(PG8_SB(0, 1), b2 + hstepB, voffB);
            PG8_WAIT_V(6); PG8_BAR; PG8_MMA(1, 1, At, B1); PG8_BAR;
            PG8_LDB(B0, 1, 0); PG8_SCHED; PG8_LDA(At, 1, 0); PG8_STAGE(PG8_SA(0, 1), a2 + hstepA, voffA);
            PG8_WAIT_L(8); PG8_BAR; PG8_WAIT_L(0); PG8_MMA(0, 0, At, B0); PG8_BAR; PG8_SCHED;
            PG8_LDB(B1, 1, 1); PG8_STAGE(PG8_SB(1, 0), b3, voffB);
            PG8_BAR; PG8_WAIT_L(0); PG8_MMA(0, 1, At, B1); PG8_BAR;
            PG8_LDA(At, 1, 1); PG8_STAGE(PG8_SA(1, 0), a3, voffA);
            PG8_BAR; PG8_WAIT_L(0); PG8_MMA(1, 0, At, B0); PG8_BAR; PG8_SCHED;
            PG8_STAGE(PG8_SB(1, 1), b3 + hstepB, voffB);
            PG8_WAIT_V(6); PG8_BAR; PG8_MMA(1, 1, At, B1); PG8_BAR;
            }
        }
        if constexpr (ALIGN_EPI) { if (wr == 0) PG8_BAR; }
        E(acc, cur, wr, wc, fr, fq);
        if (!has_next) break;
#pragma unroll
        for (int a = 0; a < 2; ++a)
#pragma unroll
            for (int b = 0; b < 2; ++b)
#pragma unroll
                for (int m = 0; m < 4; ++m)
#pragma unroll
                    for (int n = 0; n < 2; ++n) acc[a][b][m][n] = (f32x4){0.f, 0.f, 0.f, 0.f};
        cur = nxt; cA = nA; cB = nB; ++ui;
        if constexpr (ALIGN_EPI) { if (wr == 1) PG8_BAR; }
    }
    PG8_WAIT_V(0);
    if constexpr (!ALIGN_EPI) { if (wr == 0) PG8_BAR; }
    PG8_BAR;
#undef PG8_SA
#undef PG8_SB
#undef PG8_STAGE
#undef PG8_LDA
#undef PG8_LDB
#undef PG8_MMA
#undef PG8_WAIT_V
#undef PG8_WAIT_L
#undef PG8_BAR
#undef PG8_SCHED
}
}

constexpr int NWAVES = 8;
constexpr int BATCH = 8, SEQ = 4096, D = 1024, T = BATCH * SEQ;
constexpr int NPROJ = 2848, NPROJ_PAD = 3072, DFF = 2816, MEMT = 256;
constexpr int C_NQ = 0, C_KC = 512, C_VC = 640, C_KSL = 768, C_VSL = 896, C_KWN = 1024, C_VWN = 1152, C_GT = 1280, C_MQ = 1304, C_MK = 1560, C_MV = 1816, C_MI = 2328, C_MF = 2332, C_MO = 2336;
constexpr float EPS = 1e-6f;
constexpr int NPHASE = 17;

constexpr size_t MiB = 1u << 20;
constexpr size_t WS_CTL = 0, CTL_ZERO_BYTES = 1 * MiB;
constexpr size_t WS_WIN = 2 * MiB, WS_WOUT = 8 * MiB, WS_WXQ = 10 * MiB, WS_WXKV = 12 * MiB, WS_WXO = 16 * MiB, WS_WGU = 18 * MiB, WS_WDN = 29 * MiB, WS_WC1 = 35 * MiB;
constexpr size_t WS_MEMN = 37 * MiB, WS_MEMK = 41 * MiB, WS_VT = 45 * MiB, WS_CKV = 49 * MiB, WS_HID = 58 * MiB, WS_KCMP = 62 * MiB;
constexpr size_t WS_H = 64 * MiB, WS_PROJ = 128 * MiB, WS_Y1 = 128 * MiB, WS_ACT = 128 * MiB, WS_YMIX = 320 * MiB, WS_QX = 320 * MiB, WS_Y2 = 320 * MiB, WS_OX = 384 * MiB, WS_CU = 384 * MiB;
constexpr size_t WS_P = 448 * MiB, WS_MQK = 448 * MiB, WS_SMALL = 480 * MiB, WS_END = 512 * MiB;
constexpr size_t SM_BC = 0, SM_GC = 1 * MiB, SM_PM = 2 * MiB, SM_NU = 3 * MiB, SM_MST = 4 * MiB, SM_DEC = 4 * MiB + 65536;
constexpr int CW_TMO = 0, CW_BAR = 4096, CW_CB1 = 16384;

constexpr int RING_BYTES = 131072, LDSCTL_OFF = RING_BYTES, MISC_OFF = LDSCTL_OFF + 320, SCR_OFF = RING_BYTES + 512, LDS_BYTES = 147456;

#define GAS __attribute__((address_space(1)))
#define LAS __attribute__((address_space(3)))
typedef unsigned short bf16;
typedef unsigned v4u __attribute__((ext_vector_type(4)));
typedef float f32x4 __attribute__((ext_vector_type(4)));
typedef GAS unsigned gu32;
#define RLX_AGENT __ATOMIC_RELAXED, __HIP_MEMORY_SCOPE_AGENT
#define LDS_WAIT() asm volatile("s_waitcnt lgkmcnt(0)" ::: "memory")
__device__ __forceinline__ unsigned f2bf(float f) { unsigned u = __builtin_bit_cast(unsigned, f); return (u + 0x7fffu + ((u >> 16) & 1u)) >> 16; }
__device__ __forceinline__ unsigned pk2(float lo, float hi) { return f2bf(lo) | (f2bf(hi) << 16); }
__device__ __forceinline__ float bf2f(unsigned short h) { return __uint_as_float(((unsigned)h) << 16); }
__device__ __forceinline__ float bflo(unsigned w) { return __uint_as_float(w << 16); }
__device__ __forceinline__ float bfhi(unsigned w) { return __uint_as_float(w & 0xffff0000u); }
__device__ __forceinline__ float sigmoid_f(float v) { return 1.0f / (1.0f + __expf(-v)); }

#define XB_TMO      128
#define XB_XCNT(j)  (256  + 64 * (j))
#define XB_XSUB(j)  (1280 + 64 * (j))
#define XB_XGEN(j)  (2304 + 64 * (j))
#define XB_TOP      3328
#define XB_TOPGEN   3392
#define XCD_BAR_WORDS 3456
#define XB_SPIN_CAP (1u << 18)
__device__ __forceinline__ unsigned xb_ld(unsigned* p)              { return __hip_atomic_load(p, __ATOMIC_RELAXED, __HIP_MEMORY_SCOPE_AGENT); }
__device__ __forceinline__ unsigned xb_add(unsigned* p, unsigned v) { return __hip_atomic_fetch_add(p, v, __ATOMIC_RELAXED, __HIP_MEMORY_SCOPE_AGENT); }
__device__ __forceinline__ unsigned xb_xcc_id() { return (unsigned)__builtin_amdgcn_s_getreg((3 << 11) | 20) & 0xFu; }
#define XB_SPIN(cond, bar) do { unsigned _sp = 0; while (cond) { __builtin_amdgcn_s_sleep(1); \
    if ((++_sp & 255u) == 0u) { if (xb_ld(&(bar)[XB_TMO])) break; if (_sp > XB_SPIN_CAP) { atomicAdd(&(bar)[XB_TMO], 1u); break; } } } } while (0)
struct XcdBarrier { unsigned* bar; unsigned x; volatile LAS unsigned* st; };
__device__ __forceinline__ XcdBarrier xcd_barrier_post(unsigned* bar, volatile LAS unsigned* st) {
    XcdBarrier b; b.bar = bar; b.x = xb_xcc_id(); b.st = st;
    if (threadIdx.x == 0) (void)xb_add(&bar[XB_XCNT(b.x)], 1u);
    return b;
}
__device__ __forceinline__ void xcd_barrier_complete(unsigned* bar, unsigned x, unsigned& nloc, unsigned& nx) {
    const unsigned G = gridDim.x * gridDim.y * gridDim.z;
    unsigned sum, cnt, mine, sp = 0u;
    for (;;) {
        sum = 0u; cnt = 0u; mine = 0u;
#pragma unroll
        for (unsigned j = 0; j < 16; ++j) { const unsigned c = xb_ld(&bar[XB_XCNT(j)]); sum += c; cnt += (c > 0u) ? 1u : 0u; mine = (j == x) ? c : mine; }
        if (sum == G) break;
        __builtin_amdgcn_s_sleep(1);
        if ((++sp & 255u) == 0u) { if (xb_ld(&bar[XB_TMO])) break; if (sp > XB_SPIN_CAP) { atomicAdd(&bar[XB_TMO], 1u); break; } }
    }
    nloc = mine > 0u ? mine : 1u; nx = cnt > 0u ? cnt : 1u;
}
__device__ __forceinline__ void xcd_barrier(const XcdBarrier& b) {
    asm volatile("s_waitcnt vmcnt(0)" ::: "memory");
    __syncthreads();
    if (threadIdx.x == 0) {
        unsigned* bar = b.bar;
        __builtin_amdgcn_s_waitcnt(0);
        unsigned nloc = b.st[0], nx = b.st[1];
        if (nloc == 0u) { xcd_barrier_complete(bar, b.x, nloc, nx); b.st[0] = nloc; b.st[1] = nx; }
        const unsigned old = xb_add(&bar[XB_XSUB(b.x)], 1u);
        const unsigned gen = old / nloc;
        if (old + 1u == (gen + 1u) * nloc) {
            __builtin_amdgcn_fence(__ATOMIC_RELEASE, "agent");
            asm volatile("s_waitcnt vmcnt(0)" ::: "memory");
            const unsigned og = xb_add(&bar[XB_TOP], 1u);
            const unsigned tg = og / nx;
            if (og + 1u == (tg + 1u) * nx) xb_add(&bar[XB_TOPGEN], 1u);
            else XB_SPIN(xb_ld(&bar[XB_TOPGEN]) == tg, bar);
            __builtin_amdgcn_fence(__ATOMIC_ACQUIRE, "agent");
            xb_add(&bar[XB_XGEN(b.x)], 1u);
            asm volatile("s_waitcnt vmcnt(0)" ::: "memory");
        } else {
            XB_SPIN(xb_ld(&bar[XB_XGEN(b.x)]) == gen, bar);
            __builtin_amdgcn_fence(__ATOMIC_ACQUIRE, "agent");
            asm volatile("s_waitcnt vmcnt(0)" ::: "memory");
        }
    }
    __syncthreads();
}

__device__ __forceinline__ float wave_sum(float v) {
#pragma unroll
    for (int o = 1; o < 64; o <<= 1) v += __shfl_xor(v, o);
    return v;
}
__device__ __forceinline__ float wave_max(float v) {
#pragma unroll
    for (int o = 1; o < 64; o <<= 1) v = fmaxf(v, __shfl_xor(v, o));
    return v;
}
__device__ const unsigned char kBucket[129] = {
    0, 1, 2, 3, 4, 5, 6, 7, 8, 9, 10, 11, 12, 13, 14, 15, 16, 16, 16, 17, 17, 18, 18, 18, 19, 19, 19, 20, 20, 20, 20, 21, 21, 21, 21, 22, 22, 22, 22, 22,
    23, 23, 23, 23, 23, 23, 24, 24, 24, 24, 24, 24, 25, 25, 25, 25, 25, 25, 25, 26, 26, 26, 26, 26, 26, 26, 26, 27, 27, 27, 27, 27, 27, 27, 27, 27, 27,
    28, 28, 28, 28, 28, 28, 28, 28, 28, 28, 29, 29, 29, 29, 29, 29, 29, 29, 29, 29, 29, 29, 30, 30, 30, 30, 30, 30, 30, 30, 30, 30, 30, 30, 30, 30,
    31, 31, 31, 31, 31, 31, 31, 31, 31, 31, 31, 31, 31, 31, 31, 31};

__device__ __forceinline__ void transpose_item(const float* W, int N, bf16* WT, int ldt, int k0, int n0, int drow0, LAS float* scr, int lane) {
#pragma unroll 8
    for (int i = 0; i < 32; ++i) { const int kk = 2 * i + (lane >> 5); scr[kk * 33 + (lane & 31)] = W[(size_t)(k0 + kk) * N + n0 + (lane & 31)]; }
    LDS_WAIT(); asm volatile("" ::: "memory");
    const int c = lane & 7;
#pragma unroll
    for (int j = 0; j < 4; ++j) { const int n = (lane >> 3) + 8 * j; const LAS float* s = scr + (8 * c) * 33 + n;
        v4u o; o.x = pk2(s[0 * 33], s[1 * 33]); o.y = pk2(s[2 * 33], s[3 * 33]); o.z = pk2(s[4 * 33], s[5 * 33]); o.w = pk2(s[6 * 33], s[7 * 33]);
        *(GAS v4u*)(WT + (size_t)(drow0 + n) * ldt + k0 + 8 * c) = o; }
    LDS_WAIT(); asm volatile("" ::: "memory");
}
__device__ __forceinline__ void rms_row_to_bf16(const float* xrow, const float* gain, bf16* orow, int lane) {
    const GAS f32x4* xr = (const GAS f32x4*)xrow + lane; const GAS f32x4* gr = (const GAS f32x4*)gain + lane;
    f32x4 v[4]; float s = 0.f;
#pragma unroll
    for (int j = 0; j < 4; ++j) { v[j] = xr[64 * j]; s += (v[j].x * v[j].x + v[j].y * v[j].y) + (v[j].z * v[j].z + v[j].w * v[j].w); }
    const float rstd = 1.f / sqrtf(wave_sum(s) * (1.f / D) + EPS);
    GAS unsigned long long* o8 = (GAS unsigned long long*)orow + lane;
#pragma unroll
    for (int j = 0; j < 4; ++j) { const f32x4 g = gr[64 * j];
        o8[64 * j] = (unsigned long long)pk2(v[j].x * rstd * g.x, v[j].y * rstd * g.y) | ((unsigned long long)pk2(v[j].z * rstd * g.z, v[j].w * rstd * g.w) << 32); }
}
__device__ __forceinline__ void resnorm_row(const float* yrow, const float* xi, const float* gpost, float* xo, const float* gpre, bf16* ho, int lane) {
    const GAS f32x4* yr = (const GAS f32x4*)yrow + lane; const GAS f32x4* xr = (const GAS f32x4*)xi + lane; const GAS f32x4* gr = (const GAS f32x4*)gpost + lane;
    f32x4 v[4], x[4]; float s = 0.f;
#pragma unroll
    for (int j = 0; j < 4; ++j) { v[j] = yr[64 * j]; x[j] = xr[64 * j]; s += (v[j].x * v[j].x + v[j].y * v[j].y) + (v[j].z * v[j].z + v[j].w * v[j].w); }
    const float rstd = 1.f / sqrtf(wave_sum(s) * (1.f / D) + EPS);
    float s2 = 0.f;
#pragma unroll
    for (int j = 0; j < 4; ++j) { const f32x4 g = gr[64 * j]; x[j] = x[j] + v[j] * rstd * g; s2 += (x[j].x * x[j].x + x[j].y * x[j].y) + (x[j].z * x[j].z + x[j].w * x[j].w); }
    GAS f32x4* xw = (GAS f32x4*)xo + lane;
#pragma unroll
    for (int j = 0; j < 4; ++j) xw[64 * j] = x[j];
    if (gpre) {
        const float rstd2 = 1.f / sqrtf(wave_sum(s2) * (1.f / D) + EPS);
        const GAS f32x4* g2 = (const GAS f32x4*)gpre + lane; GAS unsigned long long* o8 = (GAS unsigned long long*)ho + lane;
#pragma unroll
        for (int j = 0; j < 4; ++j) { const f32x4 g = g2[64 * j];
            o8[64 * j] = (unsigned long long)pk2(x[j].x * rstd2 * g.x, x[j].y * rstd2 * g.y) | ((unsigned long long)pk2(x[j].z * rstd2 * g.z, x[j].w * rstd2 * g.w) << 32); }
    }
}

struct XaSOrder {
    int G, c;
    __device__ bool next(int i, pg8::Unit& u) const {
        const int L = i * G + c; if (L >= 512) return false;
        const int bz = L >> 4, pm = L & 15, b = bz >> 2, h = bz & 3;
        u.bz = bz; u.orow = b * SEQ + pm * 256; u.ocol = h * 256; return true;
    }
    __device__ __forceinline__ long offA(const pg8::Unit& u) const { return (long)u.orow * D + u.ocol; }
    __device__ __forceinline__ long offB(const pg8::Unit& u) const { return (long)((u.bz >> 2) * MEMT) * D + u.ocol; }
};
struct XaPVOrder {
    int G, c;
    __device__ bool next(int i, pg8::Unit& u) const {
        const int L = i * G + c; if (L >= 512) return false;
        const int bz = L >> 4, pm = L & 15, b = bz >> 2, h = bz & 3;
        u.bz = bz; u.orow = b * SEQ + pm * 256; u.ocol = h * 256; return true;
    }
    __device__ __forceinline__ long offA(const pg8::Unit& u) const { return (long)u.orow * D + u.ocol; }
    __device__ __forceinline__ long offB(const pg8::Unit& u) const { return (long)u.ocol * (BATCH * MEMT) + (u.bz >> 2) * MEMT; }
};
struct CmpOrder {
    int G, c;
    __device__ bool next(int i, pg8::Unit& u) const {
        const int L = i * G + c; if (L >= 32) return false;
        const int kv = L >> 4, pm = L & 15;
        u.bz = kv; u.orow = kv * 4096 + pm * 256; u.ocol = 0; return true;
    }
    __device__ __forceinline__ long offA(const pg8::Unit& u) const { return (long)u.orow * 1024; }
    __device__ __forceinline__ long offB(const pg8::Unit& u) const { return (long)u.bz * 256 * 2048; }
};

struct Args { const float* in[27]; float* out; unsigned char* ws; int ph_lo, ph_hi; };
__global__ void __launch_bounds__(NWAVES * 64, 2) hymba_fwd(Args args) {
    extern __shared__ __attribute__((aligned(16))) unsigned char lds_raw[];
    LAS unsigned char* lds = (LAS unsigned char*)lds_raw;
    volatile LAS unsigned* MISC = (volatile LAS unsigned*)(lds + MISC_OFF);
    const int tid = threadIdx.x, lane = tid & 63, wave = __builtin_amdgcn_readfirstlane(tid >> 6);
    const int G = gridDim.x; const int bx = blockIdx.x; const int vcu = (G % 8 == 0) ? (bx % 8) * (G / 8) + bx / 8 : bx;
    const int gw = vcu * NWAVES + wave, NGW = G * NWAVES;
    const long gtid = (long)vcu * 512 + tid, NGT = (long)G * 512;
    unsigned char* ws = args.ws;
    gu32* ctl = (gu32*)(ws + WS_CTL);
#define x_in ((const float*)args.in[0])
#define mem_in ((const float*)args.in[1])
#define rel_bias ((const float*)args.in[2])
#define g_mix_pre ((const float*)args.in[3])
#define w_in ((const float*)args.in[4])
#define cmp_pos_k ((const float*)args.in[5])
#define cmp_pos_v ((const float*)args.in[6])
#define cmp_w1_k ((const float*)args.in[7])
#define cmp_w2_k ((const float*)args.in[8])
#define cmp_w1_v ((const float*)args.in[9])
#define cmp_w2_v ((const float*)args.in[10])
#define conv_w ((const float*)args.in[11])
#define conv_b ((const float*)args.in[12])
#define gate_bias ((const float*)args.in[13])
#define mlstm_norm ((const float*)args.in[14])
#define w_out ((const float*)args.in[15])
#define g_mix_post ((const float*)args.in[16])
#define g_x_pre ((const float*)args.in[17])
#define g_mem ((const float*)args.in[18])
#define w_xq ((const float*)args.in[19])
#define w_xkv ((const float*)args.in[20])
#define w_xo ((const float*)args.in[21])
#define g_x_post ((const float*)args.in[22])
#define g_ffn_pre ((const float*)args.in[23])
#define w_gate_up ((const float*)args.in[24])
#define w_down ((const float*)args.in[25])
#define g_ffn_post ((const float*)args.in[26])
#define out_p (args.out)
#define Win_t ((bf16*)(ws + WS_WIN))
#define Wout_t ((bf16*)(ws + WS_WOUT))
#define Wxq_t ((bf16*)(ws + WS_WXQ))
#define Wxkv_t ((bf16*)(ws + WS_WXKV))
#define Wxo_t ((bf16*)(ws + WS_WXO))
#define Wgu_t ((bf16*)(ws + WS_WGU))
#define Wdn_t ((bf16*)(ws + WS_WDN))
#define Wc1_t ((bf16*)(ws + WS_WC1))
#define MEMN ((bf16*)(ws + WS_MEMN))
#define MEMK ((bf16*)(ws + WS_MEMK))
#define VT ((bf16*)(ws + WS_VT))
#define CKV ((bf16*)(ws + WS_CKV))
#define HID ((bf16*)(ws + WS_HID))
#define KCMP ((float*)(ws + WS_KCMP))
#define H ((bf16*)(ws + WS_H))
#define PROJ ((bf16*)(ws + WS_PROJ))
#define Y1 ((float*)(ws + WS_Y1))
#define ACT ((bf16*)(ws + WS_ACT))
#define YMIX ((bf16*)(ws + WS_YMIX))
#define QX ((bf16*)(ws + WS_QX))
#define Y2 ((float*)(ws + WS_Y2))
#define OX ((bf16*)(ws + WS_OX))
#define CU ((float*)(ws + WS_CU))
#define PB ((bf16*)(ws + WS_P))
#define MQK ((bf16*)(ws + WS_MQK))
#define Bc ((float*)(ws + WS_SMALL + SM_BC))
#define Gc ((float*)(ws + WS_SMALL + SM_GC))
#define PM ((float*)(ws + WS_SMALL + SM_PM))
#define NU ((float*)(ws + WS_SMALL + SM_NU))
#define MST ((float*)(ws + WS_SMALL + SM_MST))
#define DEC ((float*)(ws + WS_SMALL + SM_DEC))
#define CB1 ((float*)(ws + WS_CTL) + CW_CB1)
    for (int u = tid; u < (LDS_BYTES - LDSCTL_OFF) / 4; u += NWAVES * 64) ((LAS unsigned*)(lds + LDSCTL_OFF))[u] = 0u;
    __syncthreads();
    XcdBarrier bar; bar.bar = (unsigned*)ctl + CW_BAR; bar.x = 0; bar.st = nullptr;
    if (MK_ONE_LAUNCH) bar = xcd_barrier_post((unsigned*)ctl + CW_BAR, MISC + 8);
    const int lo = args.ph_lo, hi = args.ph_hi;
#if defined(DBG_MASK)
#define IN(k) (((DBG_MASK >> (k)) & 1) && lo <= (k) && (k) < hi)
#elif defined(DBG_ONLY)
#define IN(k) ((k) == DBG_ONLY && lo <= (k) && (k) < hi)
#else
#define IN(k) (lo <= (k) && (k) < hi)
#endif
#define SEAM(k) do { if (MK_ONE_LAUNCH && IN(k) && IN((k) + 1)) xcd_barrier(bar); } while (0)

    if (IN(0)) {
        LAS float* scr = (LAS float*)(lds + wave * 16384);
        constexpr int I_IN = 16 * 89, I_SQ = 16 * 32, I_KV = 16 * 64, I_GU = 16 * 176, I_DN = 44 * 32, I_C1 = 32 * 8;
        constexpr int NITEMS = I_IN + 3 * I_SQ + I_KV + I_GU + I_DN + 2 * I_C1;
        for (int it = gw; it < NITEMS; it += NGW) {
            int r = it;
            if (r < I_IN) { const int kb = r / 89, nb = r % 89; transpose_item(w_in, NPROJ, Win_t, D, 64 * kb, 32 * nb, 32 * nb, scr, lane); continue; } r -= I_IN;
            if (r < I_SQ) { const int kb = r / 32, nb = r % 32; transpose_item(w_out, D, Wout_t, D, 64 * kb, 32 * nb, 32 * nb, scr, lane); continue; } r -= I_SQ;
            if (r < I_SQ) { const int kb = r / 32, nb = r % 32; transpose_item(w_xq, D, Wxq_t, D, 64 * kb, 32 * nb, 32 * nb, scr, lane); continue; } r -= I_SQ;
            if (r < I_SQ) { const int kb = r / 32, nb = r % 32; transpose_item(w_xo, D, Wxo_t, D, 64 * kb, 32 * nb, 32 * nb, scr, lane); continue; } r -= I_SQ;
            if (r < I_KV) { const int kb = r / 64, nb = r % 64; transpose_item(w_xkv, 2 * D, Wxkv_t, D, 64 * kb, 32 * nb, 32 * nb, scr, lane); continue; } r -= I_KV;
            if (r < I_GU) { const int kb = r / 176, nb = r % 176; const int n0 = 32 * nb; const int isu = n0 >= DFF ? 1 : 0, nn = n0 - isu * DFF;
                            transpose_item(w_gate_up, 2 * DFF, Wgu_t, D, 64 * kb, n0, 256 * (nn >> 7) + 128 * isu + (nn & 127), scr, lane); continue; } r -= I_GU;
            if (r < I_DN) { const int kb = r / 32, nb = r % 32; transpose_item(w_down, D, Wdn_t, DFF, 64 * kb, 32 * nb, 32 * nb, scr, lane); continue; } r -= I_DN;
            if (r < I_C1) { const int kb = r / 8, nb = r % 8; transpose_item(cmp_w1_k, 256, Wc1_t, 2048, 64 * kb, 32 * nb, 32 * nb, scr, lane); continue; } r -= I_C1;
            { const int kb = r / 8, nb = r % 8; transpose_item(cmp_w1_v, 256, Wc1_t + 256 * 2048, 2048, 64 * kb, 32 * nb, 32 * nb, scr, lane); }
        }
        for (long i = gtid; i < (long)(NPROJ_PAD - NPROJ) * D / 8; i += NGT) ((GAS v4u*)(Win_t + (size_t)NPROJ * D))[i] = (v4u){0u, 0u, 0u, 0u};
        for (int it = gw; it < 256; it += NGW) {
            const int kv = it >> 7, nc = (it >> 5) & 3, kc = it & 31; const float* pos = kv ? cmp_pos_v : cmp_pos_k; const float* w1 = kv ? cmp_w1_v : cmp_w1_k;
            float a = 0.f;
#pragma unroll 8
            for (int kk = 0; kk < 64; ++kk) a += pos[kc * 64 + kk] * w1[(size_t)(kc * 64 + kk) * 256 + nc * 64 + lane];
            atomicAdd(&CB1[kv * 256 + nc * 64 + lane], a);
        }
        for (int m = gw; m < T; m += NGW) rms_row_to_bf16(x_in + (size_t)m * D, g_mix_pre, H + (size_t)m * D, lane);
        for (int m = gw; m < BATCH * MEMT; m += NGW) rms_row_to_bf16(mem_in + (size_t)m * D, g_mem, MEMN + (size_t)m * D, lane);
    }
    SEAM(0);

    if (IN(1)) {
        { pg8::Gemm g{H, Win_t, D, D, D}; pg8::GridOrder S; S.init(T, NPROJ_PAD, D, D, G, bx); pg8::EpiBf16 E{PROJ, NPROJ_PAD, 1.0f};
          pg8::gemm_phase<pg8::EpiBf16, pg8::GridOrder, true, true>(lds, g, S, E); }
        { pg8::Gemm g{MEMN, Wxkv_t, D, D, D}; pg8::GridOrder S; S.init(BATCH * MEMT, D, D, D, G, bx); pg8::EpiBf16 E{MEMK, D, 1.0f};
          pg8::gemm_phase<pg8::EpiBf16, pg8::GridOrder, true, true>(lds, g, S, E); }
        { pg8::Gemm g{Wxkv_t + (size_t)D * D, MEMN, D, D, D}; pg8::GridOrder S; S.init(D, BATCH * MEMT, D, D, G, bx); pg8::EpiBf16 E{VT, BATCH * MEMT, 1.0f};
          pg8::gemm_phase<pg8::EpiBf16, pg8::GridOrder, true, true>(lds, g, S, E); }
    }
    SEAM(1);

    if (IN(2)) {
        for (int bh = gw; bh < 32; bh += NGW) {
            const int b = bh >> 2, h = bh & 3; float m = 0.f; const float gbi = gate_bias[h], gbf = gate_bias[4 + h];
            if (lane == 0) MST[bh * 65] = 0.f;
            for (int k = 0; k < 64; ++k) {
                const size_t t = (size_t)b * SEQ + 64 * k + lane;
                const float ip = bf2f(PROJ[t * NPROJ_PAD + C_MI + h]) + gbi, fp = bf2f(PROJ[t * NPROJ_PAD + C_MF + h]) + gbf;
                const float lf = fminf(fp, 0.f) - log1pf(__expf(-fabsf(fp)));
                float bs = lf;
#pragma unroll
                for (int o = 1; o < 64; o <<= 1) { const float v = __shfl_up(bs, o); if (lane >= o) bs += v; }
                const float gg = ip - bs; float pmx = gg;
#pragma unroll
                for (int o = 1; o < 64; o <<= 1) { const float v = __shfl_up(pmx, o); if (lane >= o) pmx = fmaxf(pmx, v); }
                Bc[t * 4 + h] = bs; Gc[t * 4 + h] = gg; PM[t * 4 + h] = pmx;
                const float bL = __shfl(bs, 63), gmax = __shfl(pmx, 63);
                const float mn = fmaxf(bL + m, bL + gmax);
                if (lane == 0) { DEC[bh * 64 + k] = __expf(bL + m - mn); MST[bh * 65 + k + 1] = mn; }
                m = mn;
            }
        }
        for (long i = gtid; i < (long)T * 64; i += NGT) {
            const long t = i >> 6; const int c0 = (int)(i & 63) * 8, tt = (int)(t & (SEQ - 1));
            float a[8];
#pragma unroll
            for (int e = 0; e < 8; ++e) a[e] = conv_b[c0 + e];
#pragma unroll
            for (int j = 0; j < 4; ++j) { if (tt - 3 + j >= 0) { const v4u u = *(const GAS v4u*)(PROJ + (size_t)(t - 3 + j) * NPROJ_PAD + C_MQ + c0); const float* cw = conv_w + j * 512 + c0;
                a[0] += cw[0] * bflo(u.x); a[1] += cw[1] * bfhi(u.x); a[2] += cw[2] * bflo(u.y); a[3] += cw[3] * bfhi(u.y);
                a[4] += cw[4] * bflo(u.z); a[5] += cw[5] * bfhi(u.z); a[6] += cw[6] * bflo(u.w); a[7] += cw[7] * bfhi(u.w); } }
#pragma unroll
            for (int e = 0; e < 8; ++e) a[e] = a[e] * sigmoid_f(a[e]);
            v4u o; o.x = pk2(a[0], a[1]); o.y = pk2(a[2], a[3]); o.z = pk2(a[4], a[5]); o.w = pk2(a[6], a[7]);
            *(GAS v4u*)(MQK + (size_t)t * 512 + c0) = o;
        }
        for (long i = gtid; i < (long)2 * BATCH * 2 * SEQ * 8; i += NGT) {
            const int ch = (int)(i & 7); const long r = i >> 3; const int t = (int)(r & (SEQ - 1)); const int hkv = (int)((r >> 12) & 1), b = (int)((r >> 13) & 7), kv = (int)(r >> 16);
            *(GAS v4u*)(CKV + (size_t)r * 64 + ch * 8) = *(const GAS v4u*)(PROJ + ((size_t)b * SEQ + t) * NPROJ_PAD + C_KC + kv * 128 + hkv * 64 + ch * 8);
        }
    }
    SEAM(2);

    if (IN(3)) {
        { pg8::Gemm g{CKV, Wc1_t, 1024, 2048, 2048}; CmpOrder S{G, bx}; pg8::EpiSiluBias E{HID, 256, CB1};
          pg8::gemm_phase<pg8::EpiSiluBias, CmpOrder, true, true>(lds, g, S, E); }
        __syncthreads();
        LAS float* kwL = (LAS float*)lds; LAS float* vL = kwL + 64 * 64;
        for (int it = vcu; it < 2048; it += G) {
            const int bh = it >> 6, k = it & 63, b = bh >> 2, h = bh & 3; const size_t t0 = (size_t)b * SEQ + 64 * k;
            const float mnext = MST[bh * 65 + k + 1], bL = Bc[(t0 + 63) * 4 + h];
            for (int idx = tid; idx < 64 * 64; idx += 512) { const int s = idx >> 6, d = idx & 63;
                kwL[idx] = bf2f(MQK[(t0 + s) * 512 + 256 + h * 64 + d]) * 0.125f * __expf(bL + Gc[(t0 + s) * 4 + h] - mnext); }
            for (int idx = tid; idx < 64 * 128; idx += 512) { const int s = idx >> 7, vv = idx & 127; vL[idx] = bf2f(PROJ[(t0 + s) * NPROJ_PAD + C_MV + h * 128 + vv]); }
            __syncthreads();
            { const int d = tid >> 3, vg = tid & 7; f32x4 a[4] = {{0.f, 0.f, 0.f, 0.f}, {0.f, 0.f, 0.f, 0.f}, {0.f, 0.f, 0.f, 0.f}, {0.f, 0.f, 0.f, 0.f}};
              for (int s = 0; s < 64; ++s) { const float kwv = kwL[s * 64 + d]; const LAS f32x4* vp = (const LAS f32x4*)(vL + s * 128 + vg * 16);
#pragma unroll
                  for (int q = 0; q < 4; ++q) a[q] += vp[q] * kwv; }
              GAS f32x4* op = (GAS f32x4*)(CU + ((size_t)it * 64 + d) * 128 + vg * 16);
#pragma unroll
              for (int q = 0; q < 4; ++q) op[q] = a[q];
              if (tid < 64) { float un = 0.f; for (int s = 0; s < 64; ++s) un += kwL[s * 64 + tid]; NU[(size_t)it * 64 + tid] = un; } }
            __syncthreads();
        }
    }
    SEAM(3);

    if (IN(4)) {
        for (long i = gtid; i < (long)2 * 4096 * 64; i += NGT) {
            const int c = (int)(i & 63); const long r = i >> 6; const int kv = (int)(r >> 12); const float* w2 = kv ? cmp_w2_v : cmp_w2_k; const bf16* hp = HID + (size_t)r * 256;
            float a = 0.f;
#pragma unroll 8
            for (int n = 0; n < 256; ++n) a += bf2f(hp[n]) * w2[n * 64 + c];
            KCMP[i] = a;
        }
        for (long i = gtid; i < (long)32 * 8192 + 32 * 64; i += NGT) {
            if (i < (long)32 * 8192) { const int bh = (int)(i >> 13), e = (int)(i & 8191); float c = 0.f;
                for (int k = 0; k < 64; ++k) { float* p = CU + ((size_t)(bh * 64 + k)) * 8192 + e; const float u = *p; *p = c; c = DEC[bh * 64 + k] * c + u; } }
            else { const long j = i - (long)32 * 8192; const int bh = (int)(j >> 6), e = (int)(j & 63); float c = 0.f;
                for (int k = 0; k < 64; ++k) { float* p = NU + ((size_t)(bh * 64 + k)) * 64 + e; const float u = *p; *p = c; c = DEC[bh * 64 + k] * c + u; } }
        }
    }
    SEAM(4);

    if (IN(5)) {
        {
            LAS float* qL = (LAS float*)lds; LAS float* kL = qL + 64 * 65; LAS float* vL = kL + 64 * 65; LAS float* CL = vL + 64 * 128; LAS float* SL = CL + 64 * 128;
            LAS float* nL = SL + 64 * 65; LAS float* bLs = nL + 64; LAS float* GLs = bLs + 64; LAS float* mtL = GLs + 64; LAS float* aL = mtL + 64;
            for (int it = vcu; it < 2048; it += G) {
                const int bh = it >> 6, k = it & 63, b = bh >> 2, h = bh & 3; const size_t t0 = (size_t)b * SEQ + 64 * k;
                for (int idx = tid; idx < 64 * 64; idx += 512) { const int s = idx >> 6, d = idx & 63;
                    qL[s * 65 + d] = bf2f(MQK[(t0 + s) * 512 + h * 64 + d]); kL[s * 65 + d] = bf2f(MQK[(t0 + s) * 512 + 256 + h * 64 + d]) * 0.125f; }
                for (int idx = tid; idx < 64 * 128; idx += 512) { const int s = idx >> 7, vv = idx & 127; vL[idx] = bf2f(PROJ[(t0 + s) * NPROJ_PAD + C_MV + h * 128 + vv]); CL[idx] = CU[(size_t)it * 8192 + idx]; }
                if (tid < 64) { const float bt = Bc[(t0 + tid) * 4 + h], pm = PM[(t0 + tid) * 4 + h], mk = MST[bh * 65 + k]; const float mt = fmaxf(bt + mk, bt + pm);
                    mtL[tid] = mt; aL[tid] = __expf(bt + mk - mt); bLs[tid] = bt; GLs[tid] = Gc[(t0 + tid) * 4 + h]; nL[tid] = NU[(size_t)it * 64 + tid]; }
                __syncthreads();
                { const int t = tid >> 3, sg = tid & 7; float dots[8];
#pragma unroll
                  for (int j = 0; j < 8; ++j) dots[j] = 0.f;
                  for (int d = 0; d < 64; ++d) { const float qv = qL[t * 65 + d];
#pragma unroll
                      for (int j = 0; j < 8; ++j) dots[j] += qv * kL[(sg * 8 + j) * 65 + d]; }
                  const float bt = bLs[t], mt = mtL[t];
#pragma unroll
                  for (int j = 0; j < 8; ++j) { const int s = sg * 8 + j; SL[t * 65 + s] = (s <= t) ? dots[j] * __expf(bt + GLs[s] - mt) : 0.f; } }
                __syncthreads();
                { const int t = tid >> 3, vg = tid & 7; f32x4 num[4] = {{0.f, 0.f, 0.f, 0.f}, {0.f, 0.f, 0.f, 0.f}, {0.f, 0.f, 0.f, 0.f}, {0.f, 0.f, 0.f, 0.f}}; float den = 0.f;
                  for (int s = 0; s < 64; ++s) { const float sv = SL[t * 65 + s]; den += sv; const LAS f32x4* vp = (const LAS f32x4*)(vL + s * 128 + vg * 16);
#pragma unroll
                      for (int q = 0; q < 4; ++q) num[q] += vp[q] * sv; }
                  const float a = aL[t]; float qn = 0.f;
                  for (int d = 0; d < 64; ++d) { const float qa = qL[t * 65 + d] * a; qn += qa * nL[d]; const LAS f32x4* cp = (const LAS f32x4*)(CL + d * 128 + vg * 16);
#pragma unroll
                      for (int q = 0; q < 4; ++q) num[q] += cp[q] * qa; }
                  den += qn;
                  const float dn = fmaxf(fabsf(den), __expf(-mtL[t])), inv = 1.0f / dn; float ss = 0.f;
#pragma unroll
                  for (int q = 0; q < 4; ++q) { num[q] = num[q] * inv; ss += (num[q].x * num[q].x + num[q].y * num[q].y) + (num[q].z * num[q].z + num[q].w * num[q].w); }
                  ss += __shfl_xor(ss, 1); ss += __shfl_xor(ss, 2); ss += __shfl_xor(ss, 4);
                  const float rstd = 1.0f / sqrtf(ss * (1.0f / 128.0f) + EPS);
                  const int c0 = h * 128 + vg * 16; const bf16* mo = PROJ + (t0 + t) * NPROJ_PAD + C_MO + c0; const float* gn = mlstm_norm + c0;
                  unsigned w[8];
#pragma unroll
                  for (int q = 0; q < 4; ++q) { const float y0 = sigmoid_f(bf2f(mo[q * 4 + 0])) * (num[q].x * rstd * gn[q * 4 + 0]), y1 = sigmoid_f(bf2f(mo[q * 4 + 1])) * (num[q].y * rstd * gn[q * 4 + 1]);
                      const float y2 = sigmoid_f(bf2f(mo[q * 4 + 2])) * (num[q].z * rstd * gn[q * 4 + 2]), y3 = sigmoid_f(bf2f(mo[q * 4 + 3])) * (num[q].w * rstd * gn[q * 4 + 3]);
                      w[q * 2] = pk2(y0, y1); w[q * 2 + 1] = pk2(y2, y3); }
                  GAS v4u* op = (GAS v4u*)(YMIX + (t0 + t) * D + 512 + c0); op[0] = (v4u){w[0], w[1], w[2], w[3]}; op[1] = (v4u){w[4], w[5], w[6], w[7]}; }
                __syncthreads();
            }
        }
        {
            LAS float* biasT = (LAS float*)lds;
            LAS f32x4* qs = (LAS f32x4*)(lds + 8192 + wave * 5120);
            LAS f32x4* ps = qs + 64;
            for (int idx = tid; idx < 8 * 132; idx += 512) { const int hh = idx / 132, d = idx % 132; biasT[idx] = rel_bias[hh * 32 + kBucket[d < 128 ? d : 128]]; }
            __syncthreads();
            for (int item = gw; item < BATCH * 2 * SEQ; item += NGW) {
                const int t = item & (SEQ - 1), hkv = (item >> 12) & 1, b = item >> 13;
                const size_t row = (size_t)b * SEQ + t; const bf16* prow = PROJ + row * NPROJ_PAD;
                const LAS float* bT = biasT + (hkv * 4) * 132;
                { f32x4 qv; qv.x = bf2f(prow[(hkv * 4 + 0) * 64 + lane]) * 0.125f; qv.y = bf2f(prow[(hkv * 4 + 1) * 64 + lane]) * 0.125f;
                  qv.z = bf2f(prow[(hkv * 4 + 2) * 64 + lane]) * 0.125f; qv.w = bf2f(prow[(hkv * 4 + 3) * 64 + lane]) * 0.125f; qs[lane] = qv; }
                LDS_WAIT();
                int ncv = (t >= 31) ? ((t - 31) >> 4) + 1 : 0; if (ncv > 255) ncv = 255;
                const float* kc = KCMP + ((size_t)(0 * BATCH + b) * 2 + hkv) * 256 * 64; const float* vc = KCMP + ((size_t)(1 * BATCH + b) * 2 + hkv) * 256 * 64;
                f32x4 sc[4];
#pragma unroll
                for (int r = 0; r < 4; ++r) { const int c = lane + 64 * r; const bool valid = c < ncv; const int cc = c < 255 ? c : 254; const GAS f32x4* kr = (const GAS f32x4*)(kc + (size_t)cc * 64);
                    f32x4 dsum = {0.f, 0.f, 0.f, 0.f};
#pragma unroll 4
                    for (int d4 = 0; d4 < 16; ++d4) { const f32x4 kk = kr[d4]; dsum += qs[d4 * 4 + 0] * kk.x; dsum += qs[d4 * 4 + 1] * kk.y; dsum += qs[d4 * 4 + 2] * kk.z; dsum += qs[d4 * 4 + 3] * kk.w; }
                    int dd = t - (16 * cc + 31); dd = dd < 0 ? 0 : (dd > 128 ? 128 : dd);
                    dsum.x += bT[dd]; dsum.y += bT[132 + dd]; dsum.z += bT[264 + dd]; dsum.w += bT[396 + dd];
                    sc[r] = valid ? dsum : (f32x4){-1e30f, -1e30f, -1e30f, -1e30f}; }
                f32x4 mx; mx.x = wave_max(fmaxf(fmaxf(sc[0].x, sc[1].x), fmaxf(sc[2].x, sc[3].x))); mx.y = wave_max(fmaxf(fmaxf(sc[0].y, sc[1].y), fmaxf(sc[2].y, sc[3].y)));
                mx.z = wave_max(fmaxf(fmaxf(sc[0].z, sc[1].z), fmaxf(sc[2].z, sc[3].z))); mx.w = wave_max(fmaxf(fmaxf(sc[0].w, sc[1].w), fmaxf(sc[2].w, sc[3].w)));
                f32x4 lsum = {0.f, 0.f, 0.f, 0.f};
#pragma unroll
                for (int r = 0; r < 4; ++r) { const bool valid = (lane + 64 * r) < ncv; f32x4 p; p.x = valid ? __expf(sc[r].x - mx.x) : 0.f; p.y = valid ? __expf(sc[r].y - mx.y) : 0.f;
                    p.z = valid ? __expf(sc[r].z - mx.z) : 0.f; p.w = valid ? __expf(sc[r].w - mx.w) : 0.f; sc[r] = p; lsum += p; }
                lsum.x = wave_sum(lsum.x); lsum.y = wave_sum(lsum.y); lsum.z = wave_sum(lsum.z); lsum.w = wave_sum(lsum.w);
                f32x4 linv; linv.x = ncv > 0 ? 1.0f / lsum.x : 0.f; linv.y = ncv > 0 ? 1.0f / lsum.y : 0.f; linv.z = ncv > 0 ? 1.0f / lsum.z : 0.f; linv.w = ncv > 0 ? 1.0f / lsum.w : 0.f;
#pragma unroll
                for (int r = 0; r < 4; ++r) ps[lane + 64 * r] = sc[r] * linv;
                LDS_WAIT();
                f32x4 oc = {0.f, 0.f, 0.f, 0.f};
                for (int c = 0; c < ncv; ++c) { const f32x4 pv = ps[c]; const float vv = vc[(size_t)c * 64 + lane]; oc += pv * vv; }
                float imp = 0.f;
                { const int c0 = 4 * lane - 1 < 0 ? 0 : 4 * lane - 1, c1 = 4 * lane + 3 > 254 ? 254 : 4 * lane + 3;
                  for (int c = c0; c <= c1; ++c) { const f32x4 pv = ps[c]; imp += (pv.x + pv.y) + (pv.z + pv.w); } }
                const int cur = t >> 6;
                const bool forced = (lane == 0) || (lane == cur) || (lane == cur - 1);
                const float score = forced ? 1.0e4f : (lane <= cur ? imp : -1.0f);
                int rank = 0;
#pragma unroll 4
                for (int i = 0; i < 64; ++i) { const float si = __int_as_float(__builtin_amdgcn_readlane(__float_as_int(score), i)); rank += ((si > score) || (si == score && i < lane)) ? 1 : 0; }
                unsigned long long sel = __ballot(rank < 16);
                sel &= (cur == 63) ? ~0ull : ((1ull << (cur + 1)) - 1ull);
                LDS_WAIT();
                f32x4 mS = {-1e30f, -1e30f, -1e30f, -1e30f}, lS = {0.f, 0.f, 0.f, 0.f}, oS = {0.f, 0.f, 0.f, 0.f};
                while (sel) {
                    const int j = __builtin_ctzll(sel); sel &= sel - 1ull;
                    const int kpos = 64 * j + lane; const bool valid = kpos <= t;
                    const GAS v4u* kr = (const GAS v4u*)(PROJ + ((size_t)b * SEQ + kpos) * NPROJ_PAD + C_KSL + 64 * hkv);
                    f32x4 dsum = {0.f, 0.f, 0.f, 0.f};
#pragma unroll
                    for (int c8 = 0; c8 < 8; ++c8) { const v4u kk = kr[c8];
                        dsum += qs[c8 * 8 + 0] * bflo(kk.x); dsum += qs[c8 * 8 + 1] * bfhi(kk.x); dsum += qs[c8 * 8 + 2] * bflo(kk.y); dsum += qs[c8 * 8 + 3] * bfhi(kk.y);
                        dsum += qs[c8 * 8 + 4] * bflo(kk.z); dsum += qs[c8 * 8 + 5] * bfhi(kk.z); dsum += qs[c8 * 8 + 6] * bflo(kk.w); dsum += qs[c8 * 8 + 7] * bfhi(kk.w); }
                    int dd = t - kpos; dd = dd < 0 ? 0 : (dd > 128 ? 128 : dd);
                    dsum.x += bT[dd]; dsum.y += bT[132 + dd]; dsum.z += bT[264 + dd]; dsum.w += bT[396 + dd];
                    if (!valid) dsum = (f32x4){-1e30f, -1e30f, -1e30f, -1e30f};
                    f32x4 mn; mn.x = fmaxf(mS.x, wave_max(dsum.x)); mn.y = fmaxf(mS.y, wave_max(dsum.y)); mn.z = fmaxf(mS.z, wave_max(dsum.z)); mn.w = fmaxf(mS.w, wave_max(dsum.w));
                    f32x4 scl; scl.x = __expf(mS.x - mn.x); scl.y = __expf(mS.y - mn.y); scl.z = __expf(mS.z - mn.z); scl.w = __expf(mS.w - mn.w);
                    f32x4 p; p.x = valid ? __expf(dsum.x - mn.x) : 0.f; p.y = valid ? __expf(dsum.y - mn.y) : 0.f; p.z = valid ? __expf(dsum.z - mn.z) : 0.f; p.w = valid ? __expf(dsum.w - mn.w) : 0.f;
                    lS.x = lS.x * scl.x + wave_sum(p.x); lS.y = lS.y * scl.y + wave_sum(p.y); lS.z = lS.z * scl.z + wave_sum(p.z); lS.w = lS.w * scl.w + wave_sum(p.w);
                    oS = oS * scl; mS = mn;
                    ps[lane] = p; LDS_WAIT();
                    const int khi = (t - 64 * j) < 63 ? (t - 64 * j) : 63;
                    const bf16* vb = PROJ + ((size_t)b * SEQ + 64 * j) * NPROJ_PAD + C_VSL + 64 * hkv + lane;
                    for (int k = 0; k <= khi; ++k) { const f32x4 pv = ps[k]; const float vv = bf2f(vb[(size_t)k * NPROJ_PAD]); oS += pv * vv; }
                    LDS_WAIT();
                }
                f32x4 mW = {-1e30f, -1e30f, -1e30f, -1e30f}, lW = {0.f, 0.f, 0.f, 0.f}, oW = {0.f, 0.f, 0.f, 0.f};
                const int wlo = t - 511 < 0 ? 0 : t - 511;
                for (int r = 0; r < 9; ++r) {
                    const int base = (t & ~63) - 512 + 64 * r;
                    if (base + 63 < wlo || base > t) continue;
                    const int kpos = base + lane; const bool valid = (kpos >= wlo) && (kpos <= t); const int kp = kpos < 0 ? 0 : kpos;
                    const GAS v4u* kr = (const GAS v4u*)(PROJ + ((size_t)b * SEQ + kp) * NPROJ_PAD + C_KWN + 64 * hkv);
                    f32x4 dsum = {0.f, 0.f, 0.f, 0.f};
#pragma unroll
                    for (int c8 = 0; c8 < 8; ++c8) { const v4u kk = kr[c8];
                        dsum += qs[c8 * 8 + 0] * bflo(kk.x); dsum += qs[c8 * 8 + 1] * bfhi(kk.x); dsum += qs[c8 * 8 + 2] * bflo(kk.y); dsum += qs[c8 * 8 + 3] * bfhi(kk.y);
                        dsum += qs[c8 * 8 + 4] * bflo(kk.z); dsum += qs[c8 * 8 + 5] * bfhi(kk.z); dsum += qs[c8 * 8 + 6] * bflo(kk.w); dsum += qs[c8 * 8 + 7] * bfhi(kk.w); }
                    int dd = t - kpos; dd = dd < 0 ? 0 : (dd > 128 ? 128 : dd);
                    dsum.x += bT[dd]; dsum.y += bT[132 + dd]; dsum.z += bT[264 + dd]; dsum.w += bT[396 + dd];
                    if (!valid) dsum = (f32x4){-1e30f, -1e30f, -1e30f, -1e30f};
                    f32x4 mn; mn.x = fmaxf(mW.x, wave_max(dsum.x)); mn.y = fmaxf(mW.y, wave_max(dsum.y)); mn.z = fmaxf(mW.z, wave_max(dsum.z)); mn.w = fmaxf(mW.w, wave_max(dsum.w));
                    f32x4 scl; scl.x = __expf(mW.x - mn.x); scl.y = __expf(mW.y - mn.y); scl.z = __expf(mW.z - mn.z); scl.w = __expf(mW.w - mn.w);
                    f32x4 p; p.x = valid ? __expf(dsum.x - mn.x) : 0.f; p.y = valid ? __expf(dsum.y - mn.y) : 0.f; p.z = valid ? __expf(dsum.z - mn.z) : 0.f; p.w = valid ? __expf(dsum.w - mn.w) : 0.f;
                    lW.x = lW.x * scl.x + wave_sum(p.x); lW.y = lW.y * scl.y + wave_sum(p.y); lW.z = lW.z * scl.z + wave_sum(p.z); lW.w = lW.w * scl.w + wave_sum(p.w);
                    oW = oW * scl; mW = mn;
                    ps[lane] = p; LDS_WAIT();
                    const int klo = wlo - base < 0 ? 0 : wlo - base, khi = (t - base) < 63 ? (t - base) : 63;
                    const long vrow0 = (long)b * SEQ + base;
                    for (int k = klo; k <= khi; ++k) { const f32x4 pv = ps[k]; const float vv = bf2f(PROJ[(size_t)(vrow0 + k) * NPROJ_PAD + C_VWN + 64 * hkv + lane]); oW += pv * vv; }
                    LDS_WAIT();
                }
                const bf16* gp = prow + C_GT + (hkv * 4) * 3;
                float res[4];
#pragma unroll
                for (int g = 0; g < 4; ++g) { const float gc = sigmoid_f(bf2f(gp[g * 3 + 0])), gs = sigmoid_f(bf2f(gp[g * 3 + 1])), gwn = sigmoid_f(bf2f(gp[g * 3 + 2]));
                    res[g] = gc * oc[g] + gs * (oS[g] / lS[g]) + gwn * (oW[g] / lW[g]); }
#pragma unroll
                for (int g = 0; g < 4; ++g) YMIX[row * D + (hkv * 4 + g) * 64 + lane] = (bf16)f2bf(res[g]);
            }
            __syncthreads();
        }
    }
    SEAM(5);

    if (IN(6)) { pg8::Gemm g{YMIX, Wout_t, D, D, D}; pg8::GridOrder S; S.init(T, D, D, D, G, bx); pg8::EpiF32 E{Y1, D};
        pg8::gemm_phase<pg8::EpiF32, pg8::GridOrder, true, true>(lds, g, S, E); }
    SEAM(6);
    if (IN(7)) { for (int m = gw; m < T; m += NGW) resnorm_row(Y1 + (size_t)m * D, x_in + (size_t)m * D, g_mix_post, out_p + (size_t)m * D, g_x_pre, H + (size_t)m * D, lane); }
    SEAM(7);
    if (IN(8)) { pg8::Gemm g{H, Wxq_t, D, D, D}; pg8::GridOrder S; S.init(T, D, D, D, G, bx); pg8::EpiBf16 E{QX, D, 0.0625f};
        pg8::gemm_phase<pg8::EpiBf16, pg8::GridOrder, true, true>(lds, g, S, E); }
    SEAM(8);
    if (IN(9)) { pg8::Gemm g{QX, MEMK, D, D, 256}; XaSOrder S{G, bx}; pg8::EpiF32 E{Y1, D};
        pg8::gemm_phase<pg8::EpiF32, XaSOrder, true, true>(lds, g, S, E); }
    SEAM(9);
    if (IN(10)) {
        for (int m = gw; m < T; m += NGW) {
            const GAS f32x4* sr = (const GAS f32x4*)(Y1 + (size_t)m * D) + lane; GAS unsigned long long* o8 = (GAS unsigned long long*)(PB + (size_t)m * D) + lane;
#pragma unroll
            for (int h = 0; h < 4; ++h) { const f32x4 v = sr[64 * h]; const float mx = wave_max(fmaxf(fmaxf(v.x, v.y), fmaxf(v.z, v.w)));
                f32x4 p; p.x = __expf(v.x - mx); p.y = __expf(v.y - mx); p.z = __expf(v.z - mx); p.w = __expf(v.w - mx);
                const float inv = 1.0f / wave_sum((p.x + p.y) + (p.z + p.w));
                o8[64 * h] = (unsigned long long)pk2(p.x * inv, p.y * inv) | ((unsigned long long)pk2(p.z * inv, p.w * inv) << 32); }
        }
    }
    SEAM(10);
    if (IN(11)) { pg8::Gemm g{PB, VT, D, BATCH * MEMT, 256}; XaPVOrder S{G, bx}; pg8::EpiBf16 E{OX, D, 1.0f};
        pg8::gemm_phase<pg8::EpiBf16, XaPVOrder, true, true>(lds, g, S, E); }
    SEAM(11);
    if (IN(12)) { pg8::Gemm g{OX, Wxo_t, D, D, D}; pg8::GridOrder S; S.init(T, D, D, D, G, bx); pg8::EpiF32 E{Y1, D};
        pg8::gemm_phase<pg8::EpiF32, pg8::GridOrder, true, true>(lds, g, S, E); }
    SEAM(12);
    if (IN(13)) { for (int m = gw; m < T; m += NGW) resnorm_row(Y1 + (size_t)m * D, out_p + (size_t)m * D, g_x_post, out_p + (size_t)m * D, g_ffn_pre, H + (size_t)m * D, lane); }
    SEAM(13);
    if (IN(14)) { pg8::Gemm g{H, Wgu_t, D, D, D}; pg8::GridOrder S; S.init(T, 2 * DFF, D, D, G, bx); pg8::EpiSwiglu E{ACT, DFF};
        pg8::gemm_phase<pg8::EpiSwiglu, pg8::GridOrder, true, true>(lds, g, S, E); }
    SEAM(14);
    if (IN(15)) { pg8::Gemm g{ACT, Wdn_t, DFF, DFF, DFF}; pg8::GridOrder S; S.init(T, D, DFF, DFF, G, bx); pg8::EpiF32 E{Y2, D};
        pg8::gemm_phase<pg8::EpiF32, pg8::GridOrder, true, true>(lds, g, S, E); }
    SEAM(15);
    if (IN(16)) { for (int m = gw; m < T; m += NGW) resnorm_row(Y2 + (size_t)m * D, out_p + (size_t)m * D, g_ffn_post, out_p + (size_t)m * D, nullptr, nullptr, lane); }
#undef IN
#undef SEAM
}

extern "C" void kernel_launch(void* const* d_in, const int* in_sizes, int n_in, void* d_out, int out_size, void* d_ws, size_t ws_size, hipStream_t stream) {
    static int grid = 0;
    if (grid == 0) {
        if (n_in != 27 || in_sizes[0] != T * D || out_size != T * D || ws_size < WS_END) { fprintf(stderr, "kernel_launch: unexpected shapes (n_in %d, in0 %d, out %d, ws %zu); nothing launched\n", n_in, n_in > 0 ? in_sizes[0] : -1, out_size, ws_size); grid = -1; return; }
        int dev = 0, cus = 0, per_cu = 0;
        if (hipGetDevice(&dev) != hipSuccess || hipDeviceGetAttribute(&cus, hipDeviceAttributeMultiprocessorCount, dev) != hipSuccess) { grid = -1; return; }
        if (hipFuncSetAttribute((const void*)hymba_fwd, hipFuncAttributeMaxDynamicSharedMemorySize, LDS_BYTES) != hipSuccess) { fprintf(stderr, "kernel_launch: hipFuncSetAttribute failed\n"); grid = -1; return; }
        if (hipOccupancyMaxActiveBlocksPerMultiprocessor(&per_cu, (const void*)hymba_fwd, NWAVES * 64, LDS_BYTES) != hipSuccess || per_cu < 1) fprintf(stderr, "kernel_launch: occupancy query reports %d workgroups per CU\n", per_cu);
        (void)hipGetLastError();
        grid = cus;
    }
    if (grid < 0) return;
    if (hipMemsetAsync((char*)d_ws + WS_CTL, 0, CTL_ZERO_BYTES, stream) != hipSuccess) return;
    Args a{};
    for (int i = 0; i < 27; ++i) a.in[i] = (const float*)d_in[i];
    a.out = (float*)d_out; a.ws = (unsigned char*)d_ws;
#if MK_ONE_LAUNCH
    a.ph_lo = 0; a.ph_hi = NPHASE;
    hipLaunchKernelGGL(hymba_fwd, dim3(grid), dim3(NWAVES * 64), LDS_BYTES, stream, a);
#else
    for (int p = 0; p < NPHASE; ++p) { a.ph_lo = p; a.ph_hi = p + 1; hipLaunchKernelGGL(hymba_fwd, dim3(grid), dim3(NWAVES * 64), LDS_BYTES, stream, a); }
#endif
}
```

```cpp
#include <hip/hip_runtime.h>
#include <cstdio>
#include <cstdint>

#ifndef MK_ONE_LAUNCH
#define MK_ONE_LAUNCH 1
#endif

namespace pg8 {
#define PG8_LAS __attribute__((address_space(3)))
typedef unsigned short bf16_t;
typedef short bf16x8 __attribute__((ext_vector_type(8)));
typedef float f32x4 __attribute__((ext_vector_type(4)));
typedef unsigned u32x4 __attribute__((ext_vector_type(4)));
constexpr int BM = 256, BK = 64, HALF = 128, HTB = HALF * BK * 2, STAGE_BYTES = 8 * HTB, NXCD = 8, WGM = 8;

__host__ __device__ __forceinline__ int lds_byte(int r, int c) { const int st = (r >> 4) * 2 + (c >> 5), rr = r & 15, cc = c & 31, ob = rr * 64 + cc * 2; return st * 1024 + (ob ^ (((ob >> 9) & 1) << 5)); }
__host__ __device__ __forceinline__ void stage_rc(int b, int& R, int& C) { const int st = b / 1024, sb = b % 1024, swz = sb ^ (((sb >> 9) & 1) << 5); R = (st >> 1) * 16 + swz / 64; C = (st & 1) * 32 + (swz % 64) / 2; }
__host__ __device__ __forceinline__ int perm32(int rho) { const int n = rho >> 4, i = rho & 15; return 8 * (i >> 2) + 4 * n + (i & 3); }

struct Unit { int orow, ocol, bz; };
struct Gemm { const bf16_t* A; const bf16_t* Bt; int lda, ldb, K; };

struct GridOrder {
    int nM, nN, nwg, G, c, lda, ldb;
    __device__ void init(int M, int N, int lda_, int ldb_, int G_, int c_) { nM = M / BM; nN = N / BM; nwg = nM * nN; G = G_; c = c_; lda = lda_; ldb = ldb_; }
    __device__ bool next(int i, Unit& u) const {
        const long L = (long)i * G + c; if (L >= nwg) return false;
        int wgid = (int)L; { const int q = nwg / NXCD, r = nwg % NXCD, xcd = wgid % NXCD, off = wgid / NXCD; wgid = (xcd < r ? xcd * (q + 1) : r * (q + 1) + (xcd - r) * q) + off; }
        const int nig = WGM * nN, gid = wgid / nig, fm = gid * WGM, gsz = (nM - fm) < WGM ? (nM - fm) : WGM;
        const int pm = fm + ((wgid % nig) % gsz), pn = (wgid % nig) / gsz; u.bz = 0; u.orow = pm * BM; u.ocol = pn * BM; return true;
    }
    __device__ __forceinline__ long offA(const Unit& u) const { return (long)u.orow * lda; }
    __device__ __forceinline__ long offB(const Unit& u) const { return (long)u.ocol * ldb; }
};

__device__ __forceinline__ unsigned cvt_pk_bf16(float lo, float hi) { unsigned r; asm volatile("v_cvt_pk_bf16_f32 %0, %1, %2" : "=v"(r) : "v"(lo), "v"(hi)); return r; }
__device__ __forceinline__ float silu_f(float v) { return v / (1.0f + __expf(-v)); }

struct EpiBf16 {
    static constexpr bool PERM = true;
    bf16_t* O; int ldc; float scale; float scale0; int ncol0;
    __device__ __forceinline__ void operator()(f32x4 (&acc)[2][2][4][2], const Unit& u, int wr, int wc, int fr, int fq) const {
        const int row0 = u.orow + wr * 64 + fr, col0 = u.ocol + wc * 32 + 8 * fq; const float scale = (u.ocol < ncol0) ? this->scale0 : this->scale;
#pragma unroll
        for (int ai = 0; ai < 2; ++ai)
#pragma unroll
            for (int m = 0; m < 4; ++m) { bf16_t* rowp = O + (size_t)(row0 + ai * HALF + m * 16) * ldc + col0;
#pragma unroll
                for (int bj = 0; bj < 2; ++bj) { const f32x4 v0 = acc[ai][bj][m][0] * scale, v1 = acc[ai][bj][m][1] * scale;
                    u32x4 w; w.x = cvt_pk_bf16(v0[0], v0[1]); w.y = cvt_pk_bf16(v0[2], v0[3]); w.z = cvt_pk_bf16(v1[0], v1[1]); w.w = cvt_pk_bf16(v1[2], v1[3]);
                    *(u32x4*)(rowp + bj * HALF) = w; } }
    }
};
struct EpiF32 {
    static constexpr bool PERM = false;
    float* O; int ldc;
    __device__ __forceinline__ void operator()(f32x4 (&acc)[2][2][4][2], const Unit& u, int wr, int wc, int fr, int fq) const {
        const int row0 = u.orow + wr * 64 + fr, col0 = u.ocol + wc * 32 + 4 * fq;
#pragma unroll
        for (int ai = 0; ai < 2; ++ai)
#pragma unroll
            for (int m = 0; m < 4; ++m) { float* rowp = O + (size_t)(row0 + ai * HALF + m * 16) * ldc + col0;
#pragma unroll
                for (int bj = 0; bj < 2; ++bj)
#pragma unroll
                    for (int n = 0; n < 2; ++n) *(f32x4*)(rowp + bj * HALF + n * 16) = acc[ai][bj][m][n]; }
    }
};
struct EpiSiluBias {
    static constexpr bool PERM = true;
    bf16_t* O; int ldc; const float* bias;
    __device__ __forceinline__ void operator()(f32x4 (&acc)[2][2][4][2], const Unit& u, int wr, int wc, int fr, int fq) const {
        const int row0 = u.orow + wr * 64 + fr, col0 = u.ocol + wc * 32 + 8 * fq; const float* bp = bias + u.bz * 256 + wc * 32 + 8 * fq;
        f32x4 bv[2][2];
#pragma unroll
        for (int bj = 0; bj < 2; ++bj)
#pragma unroll
            for (int n = 0; n < 2; ++n) bv[bj][n] = *(const f32x4*)(bp + bj * HALF + 4 * n);
#pragma unroll
        for (int ai = 0; ai < 2; ++ai)
#pragma unroll
            for (int m = 0; m < 4; ++m) { bf16_t* rowp = O + (size_t)(row0 + ai * HALF + m * 16) * ldc + col0;
#pragma unroll
                for (int bj = 0; bj < 2; ++bj) { f32x4 v0 = acc[ai][bj][m][0] + bv[bj][0], v1 = acc[ai][bj][m][1] + bv[bj][1];
#pragma unroll
                    for (int i = 0; i < 4; ++i) { v0[i] = silu_f(v0[i]); v1[i] = silu_f(v1[i]); }
                    u32x4 w; w.x = cvt_pk_bf16(v0[0], v0[1]); w.y = cvt_pk_bf16(v0[2], v0[3]); w.z = cvt_pk_bf16(v1[0], v1[1]); w.w = cvt_pk_bf16(v1[2], v1[3]);
                    *(u32x4*)(rowp + bj * HALF) = w; } }
    }
};
struct EpiSwiglu {
    static constexpr bool PERM = true;
    bf16_t* O; int ldc;
    __device__ __forceinline__ void operator()(f32x4 (&acc)[2][2][4][2], const Unit& u, int wr, int wc, int fr, int fq) const {
        const int row0 = u.orow + wr * 64 + fr, col0 = (u.ocol >> 1) + wc * 32 + 8 * fq;
#pragma unroll
        for (int ai = 0; ai < 2; ++ai)
#pragma unroll
            for (int m = 0; m < 4; ++m) { bf16_t* rowp = O + (size_t)(row0 + ai * HALF + m * 16) * ldc + col0;
                f32x4 v0, v1;
#pragma unroll
                for (int i = 0; i < 4; ++i) { v0[i] = silu_f(acc[ai][0][m][0][i]) * acc[ai][1][m][0][i]; v1[i] = silu_f(acc[ai][0][m][1][i]) * acc[ai][1][m][1][i]; }
                u32x4 w; w.x = cvt_pk_bf16(v0[0], v0[1]); w.y = cvt_pk_bf16(v0[2], v0[3]); w.z = cvt_pk_bf16(v1[0], v1[1]); w.w = cvt_pk_bf16(v1[2], v1[3]);
                *(u32x4*)rowp = w; }
    }
};
template <class Epi, class Sched, bool ALIGN_EPI, bool SP2>
__device__ __forceinline__ void gemm_phase(PG8_LAS unsigned char* lds, const Gemm g, const Sched& S, const Epi& E) {
    int tid_ = threadIdx.x; asm volatile("" : "+v"(tid_));
    const int tid = tid_, wid = __builtin_amdgcn_readfirstlane(tid >> 6), lane = tid & 63, wr = wid >> 2, wc = wid & 3, fr = lane & 15, fq = lane >> 4;
    const int K = g.K, nt = K / BK;
    unsigned voffA[2], voffB[2];
#pragma unroll
    for (int i = 0; i < 2; ++i) { int R, C; stage_rc(tid * 16 + i * 8192, R, C); const int Rb = Epi::PERM ? ((R & ~31) + perm32(R & 31)) : R;
        voffA[i] = (unsigned)(R * g.lda + C) * 2u; voffB[i] = (unsigned)(Rb * g.ldb + C) * 2u; }
    const size_t kstep = (size_t)(BK * 2);
    const size_t hstepA = (size_t)HALF * g.lda * 2, hstepB = (size_t)HALF * g.ldb * 2;
    const unsigned ldsw = (unsigned)wid * 1024u;
    const int aoff = lds_byte(wr * 64 + fr, fq * 8), boff = lds_byte(wc * 32 + fr, fq * 8);
#define PG8_SA(b, h) (((b) * 2 + (h)) * HTB)
#define PG8_SB(b, h) ((4 + (b) * 2 + (h)) * HTB)
#define PG8_STAGE(bufoff, gbase, voff) do { _Pragma("unroll") for (int _i = 0; _i < 2; ++_i) \
        __builtin_amdgcn_global_load_lds((const unsigned*)((const char*)(gbase) + (voff)[_i]), (PG8_LAS unsigned*)(lds + (bufoff) + ldsw + _i * 8192), 16, 0, 0); } while (0)
#define PG8_LDA(dst, b, h) do { _Pragma("unroll") for (int m = 0; m < 4; ++m) _Pragma("unroll") for (int k = 0; k < 2; ++k) dst[m][k] = *(const PG8_LAS bf16x8*)(lds + PG8_SA(b, h) + aoff + m * 2048 + k * 1024); } while (0)
#define PG8_LDB(dst, b, h) do { _Pragma("unroll") for (int n = 0; n < 2; ++n) _Pragma("unroll") for (int k = 0; k < 2; ++k) dst[n][k] = *(const PG8_LAS bf16x8*)(lds + PG8_SB(b, h) + boff + n * 2048 + k * 1024); } while (0)
#define PG8_MMA(ai, bj, At, Bt) do { __builtin_amdgcn_s_setprio(1); _Pragma("unroll") for (int m = 0; m < 4; ++m) _Pragma("unroll") for (int n = 0; n < 2; ++n) _Pragma("unroll") for (int k = 0; k < 2; ++k) \
        acc[ai][bj][m][n] = __builtin_amdgcn_mfma_f32_16x16x32_bf16(Bt[n][k], At[m][k], acc[ai][bj][m][n], 0, 0, 0); __builtin_amdgcn_s_setprio(0); } while (0)
#define PG8_WAIT_V(n) asm volatile("s_waitcnt vmcnt(" #n ")" ::: "memory")
#define PG8_WAIT_L(n) asm volatile("s_waitcnt lgkmcnt(" #n ")" ::: "memory")
#define PG8_BAR __builtin_amdgcn_s_barrier()
#define PG8_SCHED __builtin_amdgcn_sched_barrier(0)
    Unit cur, nxt; int ui = 0;
    if (!S.next(0, cur)) return;
    f32x4 acc[2][2][4][2];
#pragma unroll
    for (int a = 0; a < 2; ++a)
#pragma unroll
        for (int b = 0; b < 2; ++b)
#pragma unroll
            for (int m = 0; m < 4; ++m)
#pragma unroll
                for (int n = 0; n < 2; ++n) acc[a][b][m][n] = (f32x4){0.f, 0.f, 0.f, 0.f};
    bf16x8 At[4][2], B0[2][2], B1[2][2];
    const char* cA = (const char*)g.A + (size_t)S.offA(cur) * 2; const char* cB = (const char*)g.Bt + (size_t)S.offB(cur) * 2;
    if constexpr (SP2) {
        PG8_STAGE(PG8_SB(0, 0), cB, voffB); PG8_STAGE(PG8_SB(0, 1), cB + hstepB, voffB); PG8_STAGE(PG8_SA(0, 0), cA, voffA); PG8_STAGE(PG8_SA(0, 1), cA + hstepA, voffA);
        if (wr == 1) PG8_BAR;
        PG8_WAIT_V(2); PG8_BAR;
        PG8_STAGE(PG8_SB(1, 0), cB + kstep, voffB); PG8_STAGE(PG8_SA(1, 0), cA + kstep, voffA); PG8_STAGE(PG8_SB(1, 1), cB + hstepB + kstep, voffB);
        PG8_WAIT_V(6); PG8_BAR;
    } else {
        PG8_STAGE(PG8_SB(0, 0), cB, voffB); PG8_STAGE(PG8_SA(0, 0), cA, voffA); PG8_STAGE(PG8_SB(0, 1), cB + hstepB, voffB); PG8_STAGE(PG8_SA(0, 1), cA + hstepA, voffA);
        if (wr == 1) PG8_BAR;
        PG8_WAIT_V(4); PG8_BAR;
        PG8_STAGE(PG8_SB(1, 0), cB + kstep, voffB); PG8_STAGE(PG8_SA(1, 0), cA + kstep, voffA); PG8_STAGE(PG8_SB(1, 1), cB + hstepB + kstep, voffB);
        PG8_WAIT_V(6); PG8_BAR;
    }
    for (;;) {
        const bool has_next = S.next(ui + 1, nxt);
        const char* nA = has_next ? (const char*)g.A + (size_t)S.offA(nxt) * 2 : cA; const char* nB = has_next ? (const char*)g.Bt + (size_t)S.offB(nxt) * 2 : cB;
#pragma unroll 1
        for (int t = 0; t < nt; t += 2) {
            const bool last = (t == nt - 2);
            const char* a1 = cA + (size_t)(t + 1) * kstep;
            const char* a2 = last ? nA : cA + (size_t)(t + 2) * kstep; const char* b2 = last ? nB : cB + (size_t)(t + 2) * kstep;
            const char* a3 = a2 + kstep; const char* b3 = b2 + kstep;
            if constexpr (SP2) {
            PG8_LDB(B0, 0, 0); PG8_LDB(B1, 0, 1); PG8_SCHED; PG8_LDA(At, 0, 0); PG8_STAGE(PG8_SA(1, 1), a1 + hstepA, voffA);
            PG8_WAIT_V(8); PG8_WAIT_L(0); PG8_BAR; PG8_MMA(0, 0, At, B0); PG8_MMA(0, 1, At, B1); PG8_BAR; PG8_SCHED;
            PG8_LDA(At, 0, 1); PG8_STAGE(PG8_SB(0, 0), b2, voffB); PG8_STAGE(PG8_SB(0, 1), b2 + hstepB, voffB); PG8_STAGE(PG8_SA(0, 0), a2, voffA);
            PG8_WAIT_V(8); PG8_WAIT_L(0); PG8_BAR; PG8_MMA(1, 0, At, B0); PG8_MMA(1, 1, At, B1); PG8_BAR; PG8_SCHED;
            PG8_LDB(B0, 1, 0); PG8_LDB(B1, 1, 1); PG8_SCHED; PG8_LDA(At, 1, 0); PG8_STAGE(PG8_SA(0, 1), a2 + hstepA, voffA);
            PG8_WAIT_V(8); PG8_WAIT_L(0); PG8_BAR; PG8_MMA(0, 0, At, B0); PG8_MMA(0, 1, At, B1); PG8_BAR; PG8_SCHED;
            PG8_LDA(At, 1, 1); PG8_STAGE(PG8_SB(1, 0), b3, voffB); PG8_STAGE(PG8_SB(1, 1), b3 + hstepB, voffB); PG8_STAGE(PG8_SA(1, 0), a3, voffA);
            PG8_WAIT_V(8); PG8_WAIT_L(0); PG8_BAR; PG8_MMA(1, 0, At, B0); PG8_MMA(1, 1, At, B1); PG8_BAR; PG8_SCHED;
            } else {
            PG8_LDB(B0, 0, 0); PG8_SCHED; PG8_LDA(At, 0, 0); PG8_STAGE(PG8_SA(1, 1), a1 + hstepA, voffA);
            PG8_WAIT_L(8); PG8_BAR; PG8_WAIT_L(0); PG8_MMA(0, 0, At, B0); PG8_BAR; PG8_SCHED;
            PG8_LDB(B1, 0, 1); PG8_STAGE(PG8_SB(0, 0), b2, voffB);
            PG8_BAR; PG8_WAIT_L(0); PG8_MMA(0, 1, At, B1); PG8_BAR;
            PG8_LDA(At, 0, 1); PG8_STAGE(PG8_SA(0, 0), a2, voffA);
            PG8_BAR; PG8_WAIT_L(0); PG8_MMA(1, 0, At, B0); PG8_BAR; PG8_SCHED;
            PG8_STAGE(PG8_SB(0, 1), b2 + hstepB, voffB);
            PG8_WAIT_V(6); PG8_BAR; PG8_MMA(1, 1, At, B1); PG8_BAR;
            PG8_LDB(B0, 1, 0); PG8_SCHED; PG8_LDA(At, 1, 0); PG8_STAGE(PG8_SA(0, 1), a2 + hstepA, voffA);
            PG8_WAIT_L(8); PG8_BAR; PG8_WAIT_L(0); PG8_MMA(0, 0, At, B0); PG8_BAR; PG8_SCHED;
            PG8_LDB(B1, 1, 1); PG8_STAGE(PG8_SB(1, 0), b3, voffB);
            PG8_BAR; PG8_WAIT_L(0); PG8_MMA(0, 1, At, B1); PG8_BAR;
            PG8_LDA(At, 1, 1); PG8_STAGE(PG8_SA(1, 0), a3, voffA);
            PG8_BAR; PG8_WAIT_L(0); PG8_MMA(1, 0, At, B0); PG8_BAR; PG8_SCHED;
            PG8_STAGE(PG8_SB(1, 1), b3 + hstepB, voffB);
            PG8_WAIT_V(6); PG8_BAR; PG8_MMA(1, 1, At, B1); PG8_BAR;
            }
        }
        if constexpr (ALIGN_EPI) { if (wr == 0) PG8_BAR; }
        E(acc, cur, wr, wc, fr, fq);
        if (!has_next) break;
#pragma unroll
        for (int a = 0; a < 2; ++a)
#pragma unroll
            for (int b = 0; b < 2; ++b)
#pragma unroll
                for (int m = 0; m < 4; ++m)
#pragma unroll
                    for (int n = 0; n < 2; ++n) acc[a][b][m][n] = (f32x4){0.f, 0.f, 0.f, 0.f};
        cur = nxt; cA = nA; cB = nB; ++ui;
        if constexpr (ALIGN_EPI) { if (wr == 1) PG8_BAR; }
    }
    PG8_WAIT_V(0);
    if constexpr (!ALIGN_EPI) { if (wr == 0) PG8_BAR; }
    PG8_BAR;
#undef PG8_SA
#undef PG8_SB
#undef PG8_STAGE
#undef PG8_LDA
#undef PG8_LDB
#undef PG8_MMA
#undef PG8_WAIT_V
#undef PG8_WAIT_L
#undef PG8_BAR
#undef PG8_SCHED
}
}

constexpr int NWAVES = 8;
constexpr int BATCH = 8, SEQ = 4096, D = 1024, T = BATCH * SEQ;
constexpr int NPROJ = 2848, NPROJ_PAD = 3072, DFF = 2816, MEMT = 256;
constexpr int C_NQ = 0, C_KC = 512, C_VC = 640, C_KSL = 768, C_VSL = 896, C_KWN = 1024, C_VWN = 1152, C_GT = 1280, C_MQ = 1304, C_MK = 1560, C_MV = 1816, C_MI = 2328, C_MF = 2332, C_MO = 2336;
constexpr float EPS = 1e-6f;
constexpr int NPHASE = 18;

constexpr size_t MiB = 1u << 20;
constexpr size_t WS_CTL = 0, CTL_ZERO_BYTES = 1 * MiB;
constexpr size_t WS_WIN = 2 * MiB, WS_WOUT = 8 * MiB, WS_WXQ = 10 * MiB, WS_WXKV = 12 * MiB, WS_WXO = 16 * MiB, WS_WGU = 18 * MiB, WS_WDN = 29 * MiB, WS_WC1 = 35 * MiB;
constexpr size_t WS_MEMN = 37 * MiB, WS_MEMK = 41 * MiB, WS_VT = 45 * MiB, WS_CKV = 49 * MiB, WS_HID = 58 * MiB, WS_KCMP = 62 * MiB;
constexpr size_t WS_H = 64 * MiB, WS_PROJ = 128 * MiB, WS_Y1 = 128 * MiB, WS_ACT = 128 * MiB, WS_YMIX = 320 * MiB, WS_QX = 320 * MiB, WS_Y2 = 320 * MiB, WS_OX = 384 * MiB, WS_CU = 384 * MiB;
constexpr size_t WS_P = 448 * MiB, WS_MQK = 448 * MiB, WS_SMALL = 480 * MiB, WS_END = 512 * MiB;
constexpr size_t SM_BC = 0, SM_GC = 1 * MiB, SM_PM = 2 * MiB, SM_NU = 3 * MiB, SM_MST = 4 * MiB, SM_DEC = 4 * MiB + 65536;
constexpr int CW_TMO = 0, CW_BAR = 4096, CW_CB1 = 16384;

constexpr int RING_BYTES = 131072, LDSCTL_OFF = RING_BYTES, MISC_OFF = LDSCTL_OFF + 320, SCR_OFF = RING_BYTES + 512, LDS_BYTES = 147456;

#define GAS __attribute__((address_space(1)))
#define LAS __attribute__((address_space(3)))
typedef unsigned short bf16;
typedef unsigned v4u __attribute__((ext_vector_type(4)));
typedef float f32x4 __attribute__((ext_vector_type(4)));
typedef GAS unsigned gu32;
#define RLX_AGENT __ATOMIC_RELAXED, __HIP_MEMORY_SCOPE_AGENT
#define LDS_WAIT() asm volatile("s_waitcnt lgkmcnt(0)" ::: "memory")
__device__ __forceinline__ unsigned f2bf(float f) { unsigned u = __builtin_bit_cast(unsigned, f); return (u + 0x7fffu + ((u >> 16) & 1u)) >> 16; }
__device__ __forceinline__ unsigned pk2(float lo, float hi) { return f2bf(lo) | (f2bf(hi) << 16); }
__device__ __forceinline__ float bf2f(unsigned short h) { return __uint_as_float(((unsigned)h) << 16); }
__device__ __forceinline__ float bflo(unsigned w) { return __uint_as_float(w << 16); }
__device__ __forceinline__ float bfhi(unsigned w) { return __uint_as_float(w & 0xffff0000u); }
__device__ __forceinline__ float sigmoid_f(float v) { return 1.0f / (1.0f + __expf(-v)); }

#define XB_TMO      128
#define XB_XCNT(j)  (256  + 64 * (j))
#define XB_XSUB(j)  (1280 + 64 * (j))
#define XB_XGEN(j)  (2304 + 64 * (j))
#define XB_TOP      3328
#define XB_TOPGEN   3392
#define XCD_BAR_WORDS 3456
#define XB_SPIN_CAP (1u << 18)
__device__ __forceinline__ unsigned xb_ld(unsigned* p)              { return __hip_atomic_load(p, __ATOMIC_RELAXED, __HIP_MEMORY_SCOPE_AGENT); }
__device__ __forceinline__ unsigned xb_add(unsigned* p, unsigned v) { return __hip_atomic_fetch_add(p, v, __ATOMIC_RELAXED, __HIP_MEMORY_SCOPE_AGENT); }
__device__ __forceinline__ unsigned xb_xcc_id() { return (unsigned)__builtin_amdgcn_s_getreg((3 << 11) | 20) & 0xFu; }
#define XB_SPIN(cond, bar) do { unsigned _sp = 0; while (cond) { __builtin_amdgcn_s_sleep(1); \
    if ((++_sp & 255u) == 0u) { if (xb_ld(&(bar)[XB_TMO])) break; if (_sp > XB_SPIN_CAP) { atomicAdd(&(bar)[XB_TMO], 1u); break; } } } } while (0)
struct XcdBarrier { unsigned* bar; unsigned x; volatile LAS unsigned* st; };
__device__ __forceinline__ XcdBarrier xcd_barrier_post(unsigned* bar, volatile LAS unsigned* st) {
    XcdBarrier b; b.bar = bar; b.x = xb_xcc_id(); b.st = st;
    if (threadIdx.x == 0) (void)xb_add(&bar[XB_XCNT(b.x)], 1u);
    return b;
}
__device__ __forceinline__ void xcd_barrier_complete(unsigned* bar, unsigned x, unsigned& nloc, unsigned& nx) {
    const unsigned G = gridDim.x * gridDim.y * gridDim.z;
    unsigned sum, cnt, mine, sp = 0u;
    for (;;) {
        sum = 0u; cnt = 0u; mine = 0u;
#pragma unroll
        for (unsigned j = 0; j < 16; ++j) { const unsigned c = xb_ld(&bar[XB_XCNT(j)]); sum += c; cnt += (c > 0u) ? 1u : 0u; mine = (j == x) ? c : mine; }
        if (sum == G) break;
        __builtin_amdgcn_s_sleep(1);
        if ((++sp & 255u) == 0u) { if (xb_ld(&bar[XB_TMO])) break; if (sp > XB_SPIN_CAP) { atomicAdd(&bar[XB_TMO], 1u); break; } }
    }
    nloc = mine > 0u ? mine : 1u; nx = cnt > 0u ? cnt : 1u;
}
__device__ __forceinline__ void xcd_barrier(const XcdBarrier& b) {
    asm volatile("s_waitcnt vmcnt(0)" ::: "memory");
    __syncthreads();
    if (threadIdx.x == 0) {
        unsigned* bar = b.bar;
        __builtin_amdgcn_s_waitcnt(0);
        unsigned nloc = b.st[0], nx = b.st[1];
        if (nloc == 0u) { xcd_barrier_complete(bar, b.x, nloc, nx); b.st[0] = nloc; b.st[1] = nx; }
        const unsigned old = xb_add(&bar[XB_XSUB(b.x)], 1u);
        const unsigned gen = old / nloc;
        if (old + 1u == (gen + 1u) * nloc) {
            __builtin_amdgcn_fence(__ATOMIC_RELEASE, "agent");
            asm volatile("s_waitcnt vmcnt(0)" ::: "memory");
            const unsigned og = xb_add(&bar[XB_TOP], 1u);
            const unsigned tg = og / nx;
            if (og + 1u == (tg + 1u) * nx) xb_add(&bar[XB_TOPGEN], 1u);
            else XB_SPIN(xb_ld(&bar[XB_TOPGEN]) == tg, bar);
            __builtin_amdgcn_fence(__ATOMIC_ACQUIRE, "agent");
            xb_add(&bar[XB_XGEN(b.x)], 1u);
            asm volatile("s_waitcnt vmcnt(0)" ::: "memory");
        } else {
            XB_SPIN(xb_ld(&bar[XB_XGEN(b.x)]) == gen, bar);
            __builtin_amdgcn_fence(__ATOMIC_ACQUIRE, "agent");
            asm volatile("s_waitcnt vmcnt(0)" ::: "memory");
        }
    }
    __syncthreads();
}

__device__ __forceinline__ float wave_sum(float v) {
#pragma unroll
    for (int o = 1; o < 64; o <<= 1) v += __shfl_xor(v, o);
    return v;
}
__device__ __forceinline__ float wave_max(float v) {
#pragma unroll
    for (int o = 1; o < 64; o <<= 1) v = fmaxf(v, __shfl_xor(v, o));
    return v;
}
__device__ const unsigned char kBucket[129] = {
    0, 1, 2, 3, 4, 5, 6, 7, 8, 9, 10, 11, 12, 13, 14, 15, 16, 16, 16, 17, 17, 18, 18, 18, 19, 19, 19, 20, 20, 20, 20, 21, 21, 21, 21, 22, 22, 22, 22, 22,
    23, 23, 23, 23, 23, 23, 24, 24, 24, 24, 24, 24, 25, 25, 25, 25, 25, 25, 25, 26, 26, 26, 26, 26, 26, 26, 26, 27, 27, 27, 27, 27, 27, 27, 27, 27, 27,
    28, 28, 28, 28, 28, 28, 28, 28, 28, 28, 29, 29, 29, 29, 29, 29, 29, 29, 29, 29, 29, 29, 30, 30, 30, 30, 30, 30, 30, 30, 30, 30, 30, 30, 30, 30,
    31, 31, 31, 31, 31, 31, 31, 31, 31, 31, 31, 31, 31, 31, 31, 31};

__device__ __forceinline__ void transpose_item(const float* W, int N, bf16* WT, int ldt, int k0, int n0, int drow0, LAS float* scr, int lane) {
#pragma unroll 8
    for (int i = 0; i < 32; ++i) { const int kk = 2 * i + (lane >> 5); scr[kk * 33 + (lane & 31)] = W[(size_t)(k0 + kk) * N + n0 + (lane & 31)]; }
    LDS_WAIT(); asm volatile("" ::: "memory");
    const int c = lane & 7;
#pragma unroll
    for (int j = 0; j < 4; ++j) { const int n = (lane >> 3) + 8 * j; const LAS float* s = scr + (8 * c) * 33 + n;
        v4u o; o.x = pk2(s[0 * 33], s[1 * 33]); o.y = pk2(s[2 * 33], s[3 * 33]); o.z = pk2(s[4 * 33], s[5 * 33]); o.w = pk2(s[6 * 33], s[7 * 33]);
        *(GAS v4u*)(WT + (size_t)(drow0 + n) * ldt + k0 + 8 * c) = o; }
    LDS_WAIT(); asm volatile("" ::: "memory");
}
__device__ __forceinline__ void rms_row_to_bf16(const float* xrow, const float* gain, bf16* orow, int lane) {
    const GAS f32x4* xr = (const GAS f32x4*)xrow + lane; const GAS f32x4* gr = (const GAS f32x4*)gain + lane;
    f32x4 v[4]; float s = 0.f;
#pragma unroll
    for (int j = 0; j < 4; ++j) { v[j] = xr[64 * j]; s += (v[j].x * v[j].x + v[j].y * v[j].y) + (v[j].z * v[j].z + v[j].w * v[j].w); }
    const float rstd = 1.f / sqrtf(wave_sum(s) * (1.f / D) + EPS);
    GAS unsigned long long* o8 = (GAS unsigned long long*)orow + lane;
#pragma unroll
    for (int j = 0; j < 4; ++j) { const f32x4 g = gr[64 * j];
        o8[64 * j] = (unsigned long long)pk2(v[j].x * rstd * g.x, v[j].y * rstd * g.y) | ((unsigned long long)pk2(v[j].z * rstd * g.z, v[j].w * rstd * g.w) << 32); }
}
__device__ __forceinline__ void resnorm_row(const float* yrow, const float* xi, const float* gpost, float* xo, const float* gpre, bf16* ho, int lane) {
    const GAS f32x4* yr = (const GAS f32x4*)yrow + lane; const GAS f32x4* xr = (const GAS f32x4*)xi + lane; const GAS f32x4* gr = (const GAS f32x4*)gpost + lane;
    f32x4 v[4], x[4]; float s = 0.f;
#pragma unroll
    for (int j = 0; j < 4; ++j) { v[j] = yr[64 * j]; x[j] = xr[64 * j]; s += (v[j].x * v[j].x + v[j].y * v[j].y) + (v[j].z * v[j].z + v[j].w * v[j].w); }
    const float rstd = 1.f / sqrtf(wave_sum(s) * (1.f / D) + EPS);
    float s2 = 0.f;
#pragma unroll
    for (int j = 0; j < 4; ++j) { const f32x4 g = gr[64 * j]; x[j] = x[j] + v[j] * rstd * g; s2 += (x[j].x * x[j].x + x[j].y * x[j].y) + (x[j].z * x[j].z + x[j].w * x[j].w); }
    GAS f32x4* xw = (GAS f32x4*)xo + lane;
#pragma unroll
    for (int j = 0; j < 4; ++j) xw[64 * j] = x[j];
    if (gpre) {
        const float rstd2 = 1.f / sqrtf(wave_sum(s2) * (1.f / D) + EPS);
        const GAS f32x4* g2 = (const GAS f32x4*)gpre + lane; GAS unsigned long long* o8 = (GAS unsigned long long*)ho + lane;
#pragma unroll
        for (int j = 0; j < 4; ++j) { const f32x4 g = g2[64 * j];
            o8[64 * j] = (unsigned long long)pk2(x[j].x * rstd2 * g.x, x[j].y * rstd2 * g.y) | ((unsigned long long)pk2(x[j].z * rstd2 * g.z, x[j].w * rstd2 * g.w) << 32); }
    }
}

struct XaSOrder {
    int G, c;
    __device__ bool next(int i, pg8::Unit& u) const {
        const int L = i * G + c; if (L >= 512) return false;
        const int bz = L >> 4, pm = L & 15, b = bz >> 2, h = bz & 3;
        u.bz = bz; u.orow = b * SEQ + pm * 256; u.ocol = h * 256; return true;
    }
    __device__ __forceinline__ long offA(const pg8::Unit& u) const { return (long)u.orow * D + u.ocol; }
    __device__ __forceinline__ long offB(const pg8::Unit& u) const { return (long)((u.bz >> 2) * MEMT) * D + u.ocol; }
};
struct XaPVOrder {
    int G, c;
    __device__ bool next(int i, pg8::Unit& u) const {
        const int L = i * G + c; if (L >= 512) return false;
        const int bz = L >> 4, pm = L & 15, b = bz >> 2, h = bz & 3;
        u.bz = bz; u.orow = b * SEQ + pm * 256; u.ocol = h * 256; return true;
    }
    __device__ __forceinline__ long offA(const pg8::Unit& u) const { return (long)u.orow * D + u.ocol; }
    __device__ __forceinline__ long offB(const pg8::Unit& u) const { return (long)u.ocol * (BATCH * MEMT) + (u.bz >> 2) * MEMT; }
};
struct CmpOrder {
    int G, c;
    __device__ bool next(int i, pg8::Unit& u) const {
        const int L = i * G + c; if (L >= 32) return false;
        const int kv = L >> 4, pm = L & 15;
        u.bz = kv; u.orow = kv * 4096 + pm * 256; u.ocol = 0; return true;
    }
    __device__ __forceinline__ long offA(const pg8::Unit& u) const { return (long)u.orow * 1024; }
    __device__ __forceinline__ long offB(const pg8::Unit& u) const { return (long)u.bz * 256 * 2048; }
};

namespace nsa {
typedef short bf16x8 __attribute__((ext_vector_type(8)));
typedef short s16x4 __attribute__((ext_vector_type(4)));
typedef float f32x16 __attribute__((ext_vector_type(16)));
typedef unsigned u32x4 __attribute__((ext_vector_type(4)));
typedef unsigned u32x2 __attribute__((ext_vector_type(2)));
typedef short v4i16_t __attribute__((ext_vector_type(4)));
typedef LAS const char* lds_cptr;
constexpr int SLOTB = 8192;
constexpr int L_K = 0, L_V = 3 * SLOTB, L_IMP = 6 * SLOTB, L_SEL = L_IMP + 64 * 65 * 4, L_BIAS = L_SEL + 512, L_END = L_BIAS + 8 * 320 * 4;
constexpr float LOG2E = 1.4426950408889634f;
constexpr float QSCALE = 0.125f * LOG2E;
constexpr float FIX = 67108864.0f;
__device__ __forceinline__ int crow(int r, int hi) { return (r & 3) + 8 * (r >> 2) + 4 * hi; }
__device__ __forceinline__ void glds16(const void* gsrc, unsigned lds_dst) { unsigned keep;
    asm volatile("s_mov_b32 %0, m0\n\ts_mov_b32 m0, %2\n\ts_nop 0\n\tglobal_load_lds_dwordx4 %1, off\n\ts_mov_b32 m0, %0" : "=&s"(keep) : "v"(gsrc), "s"(lds_dst) : "memory"); }
__device__ __forceinline__ unsigned cvtpk(float lo, float hi) { unsigned r; asm("v_cvt_pk_bf16_f32 %0, %1, %2" : "=v"(r) : "v"(lo), "v"(hi)); return r; }
__device__ __forceinline__ s16x4 vtr(lds_cptr p) { return __builtin_bit_cast(s16x4, __builtin_amdgcn_ds_read_tr16_b64_v4i16((LAS v4i16_t*)p)); }
__device__ __forceinline__ float swapmax(float m) { auto rr = __builtin_amdgcn_permlane32_swap(__float_as_uint(m), __float_as_uint(m), false, false); return fmaxf(__uint_as_float(rr[0]), __uint_as_float(rr[1])); }
__device__ __forceinline__ float swapsum(float m) { auto rr = __builtin_amdgcn_permlane32_swap(__float_as_uint(m), __float_as_uint(m), false, false); return __uint_as_float(rr[0]) + __uint_as_float(rr[1]); }
#define NSA_WAIT_BAR(N) asm volatile("s_waitcnt vmcnt(" #N ") lgkmcnt(0)\n\ts_barrier" ::: "memory")

struct Tensors { const bf16* PROJ; const bf16* KCB; const bf16* VCB; bf16* Y; };

__device__ __forceinline__ void qkt(f32x16& p0, f32x16& p1, lds_cptr kb, const bf16x8 (&qr)[4]) {
    p0 = (f32x16){}; p1 = (f32x16){};
#pragma unroll
    for (int d0 = 0; d0 < 4; ++d0) { const bf16x8 b0 = *(const LAS bf16x8*)(kb + d0 * 2048), b1 = *(const LAS bf16x8*)(kb + d0 * 2048 + 512);
        p0 = __builtin_amdgcn_mfma_f32_32x32x16_bf16(b0, qr[d0], p0, 0, 0, 0); p1 = __builtin_amdgcn_mfma_f32_32x32x16_bf16(b1, qr[d0], p1, 0, 0, 0); }
}
__device__ __forceinline__ void pv(f32x16 (&o)[2], lds_cptr vp, const f32x16& p0, const f32x16& p1) {
    u32x4 pw[4];
    pw[0] = (u32x4){cvtpk(p0[0], p0[1]), cvtpk(p0[2], p0[3]), cvtpk(p0[4], p0[5]), cvtpk(p0[6], p0[7])}; pw[1] = (u32x4){cvtpk(p0[8], p0[9]), cvtpk(p0[10], p0[11]), cvtpk(p0[12], p0[13]), cvtpk(p0[14], p0[15])};
    pw[2] = (u32x4){cvtpk(p1[0], p1[1]), cvtpk(p1[2], p1[3]), cvtpk(p1[4], p1[5]), cvtpk(p1[6], p1[7])}; pw[3] = (u32x4){cvtpk(p1[8], p1[9]), cvtpk(p1[10], p1[11]), cvtpk(p1[12], p1[13]), cvtpk(p1[14], p1[15])};
#pragma unroll
    for (int d0 = 0; d0 < 2; ++d0)
#pragma unroll
        for (int ks = 0; ks < 4; ++ks) { const s16x4 lo = vtr(vp + d0 * 4096 + ks * 1024), hh = vtr(vp + d0 * 4096 + ks * 1024 + 512);
            const bf16x8 vf = (bf16x8){lo[0], lo[1], lo[2], lo[3], hh[0], hh[1], hh[2], hh[3]};
            o[d0] = __builtin_amdgcn_mfma_f32_32x32x16_bf16(vf, __builtin_bit_cast(bf16x8, pw[ks]), o[d0], 0, 0, 0); }
}
__device__ __forceinline__ void online(f32x16& p0, f32x16& p1, float& m, float& l, f32x16 (&o)[2]) {
    float rm = fmaxf(p0[0], p1[0]);
#pragma unroll
    for (int r = 1; r < 16; ++r) rm = fmaxf(rm, fmaxf(p0[r], p1[r]));
    rm = swapmax(rm);
    const float mn = fmaxf(m, rm), f = __builtin_amdgcn_exp2f(m - mn); m = mn; l *= f;
#pragma unroll
    for (int r = 0; r < 16; ++r) { o[0][r] *= f; o[1][r] *= f; }
    float s = 0.f;
#pragma unroll
    for (int r = 0; r < 16; ++r) { p0[r] = __builtin_amdgcn_exp2f(p0[r] - mn); p1[r] = __builtin_amdgcn_exp2f(p1[r] - mn); s += p0[r] + p1[r]; }
    l += s;
}
__device__ __forceinline__ void acc_o(f32x16 (&res)[2], const f32x16 (&o)[2], float sc) {
#pragma unroll
    for (int d0 = 0; d0 < 2; ++d0)
#pragma unroll
        for (int r = 0; r < 16; ++r) res[d0][r] += o[d0][r] * sc;
}
__device__ __forceinline__ void unit(const Tensors& A, int b, int hkv, int qt, LAS unsigned char* lds) {
    int tid_ = threadIdx.x; asm volatile("" : "+v"(tid_));
    const int tid = tid_, lane = tid & 63, r32 = lane & 31, hi = lane >> 5; const int wid = __builtin_amdgcn_readfirstlane(tid >> 6), g = wid >> 1, th = wid & 1, h8 = hkv * 4 + g;
    const int tl = 32 * th + r32, tq = 64 * qt + tl; const long rowb = (long)b * SEQ;
    const bf16* prow = A.PROJ + (rowb + tq) * NPROJ_PAD;
    bf16x8 qr[4];
#pragma unroll
    for (int d0 = 0; d0 < 4; ++d0) qr[d0] = *(const bf16x8*)(prow + h8 * 64 + d0 * 16 + hi * 8);
    float gateC, gateS, gateW;
    { const bf16* gp = prow + C_GT + h8 * 3; gateC = 1.0f / (1.0f + __expf(-bf2f(gp[0]))); gateS = 1.0f / (1.0f + __expf(-bf2f(gp[1]))); gateW = 1.0f / (1.0f + __expf(-bf2f(gp[2]))); }
    f32x16 res[2]; res[0] = (f32x16){}; res[1] = (f32x16){};
    const unsigned lds0 = (unsigned)(size_t)lds; const unsigned kdst = lds0 + L_K + wid * 1024, vdst = lds0 + L_V + wid * 1024;
    const lds_cptr kp0 = (lds_cptr)lds + L_K + hi * 1024 + r32 * 16;
    const lds_cptr vp0 = (lds_cptr)lds + L_V + ((lane >> 4) & 1) * 32 + (lane & 3) * 8 + (4 * hi + ((lane & 15) >> 2)) * 64;
    const LAS float* bX = (const LAS float*)(lds + L_BIAS) + h8 * 320;
    LAS unsigned* imp = (LAS unsigned*)(lds + L_IMP);
    LAS unsigned* selm = (LAS unsigned*)(lds + L_SEL);
    const float bfar = bX[64 + 128];
    const float NEG = -INFINITY;
#define NSA_KOFF(P) ((long)lane * (P) + wid * 8)
#define NSA_VOFF(P) ((long)(16 * (wid & 3) + (lane >> 2)) * (P) + (wid >> 2) * 32 + (lane & 3) * 8)
#define NSA_DMA(kb, vb, slot) do { glds16((kb), (unsigned)__builtin_amdgcn_readfirstlane(kdst + (slot))); glds16((vb), (unsigned)__builtin_amdgcn_readfirstlane(vdst + (slot))); } while (0)
    for (int i = tid; i < 64 * 65; i += 512) imp[i] = 0u;

    const int cmax = (4 * qt + 2) < 254 ? (4 * qt + 2) : 254, nct = (cmax >> 6) + 1;
    const bf16* kcb = A.KCB + (size_t)(b * 2 + hkv) * 256 * 64; const bf16* vcb = A.VCB + (size_t)(b * 2 + hkv) * 256 * 64;
    float mC = -1e30f, lC = 0.f; f32x16 oC[2]; oC[0] = (f32x16){}; oC[1] = (f32x16){};
    const int dlc = tq - 31 - 16 * 4 * hi;
#pragma unroll 1
    for (int pass = 0; pass < 2; ++pass) {
        float invl = 0.f;
        if (pass == 1) { const float lt = swapsum(lC); invl = lt > 0.f ? 1.0f / lt : 0.f; }
        { const bf16* k0 = kcb + NSA_KOFF(64); const bf16* v0 = vcb + NSA_VOFF(64); NSA_DMA(k0, v0, 0); const int t1 = nct > 1 ? 1 : 0; NSA_DMA(k0 + (long)t1 * 64 * 64, v0 + (long)t1 * 64 * 64, SLOTB); }
        int sl = 0;
#pragma unroll 1
        for (int ct = 0; ct < nct; ++ct) {
            NSA_WAIT_BAR(2);
            { const int t2 = (ct + 2 < nct) ? ct + 2 : nct - 1; const int s2 = sl >= SLOTB ? sl - SLOTB : sl + 2 * SLOTB;
              NSA_DMA(kcb + NSA_KOFF(64) + (long)t2 * 64 * 64, vcb + NSA_VOFF(64) + (long)t2 * 64 * 64, s2); }
            f32x16 p0, p1; qkt(p0, p1, kp0 + sl, qr);
            const int dt = dlc - 1024 * ct;
#pragma unroll
            for (int r = 0; r < 16; ++r) { const int kvr = (r & 3) + 8 * (r >> 2); const int d0_ = dt - 16 * kvr, d1_ = d0_ - 512;
                const int c0_ = 64 * ct + kvr + 4 * hi;
                const int i0 = d0_ < 0 ? 0 : (d0_ > 128 ? 128 : d0_), i1 = d1_ < 0 ? 0 : (d1_ > 128 ? 128 : d1_);
                p0[r] = (d0_ >= 0 && c0_ <= 254) ? p0[r] + bX[64 + i0] : NEG; p1[r] = (d1_ >= 0 && c0_ + 32 <= 254) ? p1[r] + bX[64 + i1] : NEG; }
            if (pass == 0) {
                float rm = fmaxf(p0[0], p1[0]);
#pragma unroll
                for (int r = 1; r < 16; ++r) rm = fmaxf(rm, fmaxf(p0[r], p1[r]));
                rm = swapmax(rm);
                const float mn = fmaxf(mC, rm), f = __builtin_amdgcn_exp2f(mC - mn); mC = mn; lC *= f; float s = 0.f;
#pragma unroll
                for (int r = 0; r < 16; ++r) s += __builtin_amdgcn_exp2f(p0[r] - mn) + __builtin_amdgcn_exp2f(p1[r] - mn);
                lC += s;
            } else {
#pragma unroll
                for (int r = 0; r < 16; ++r) { p0[r] = __builtin_amdgcn_exp2f(p0[r] - mC) * invl; p1[r] = __builtin_amdgcn_exp2f(p1[r] - mC) * invl; }
#pragma unroll
                for (int a = 0; a < 4; ++a) { const int j0 = 16 * ct + 2 * a + hi;
                    const float g0 = (p0[4 * a] + p0[4 * a + 1]) + (p0[4 * a + 2] + p0[4 * a + 3]), g1 = (p1[4 * a] + p1[4 * a + 1]) + (p1[4 * a + 2] + p1[4 * a + 3]);
                    __hip_atomic_fetch_add(imp + tl * 65 + j0, (unsigned)(g0 * FIX), __ATOMIC_RELAXED, __HIP_MEMORY_SCOPE_WORKGROUP);
                    __hip_atomic_fetch_add(imp + tl * 65 + j0 + 1, (unsigned)(p0[4 * a + 3] * FIX), __ATOMIC_RELAXED, __HIP_MEMORY_SCOPE_WORKGROUP);
                    __hip_atomic_fetch_add(imp + tl * 65 + j0 + 8, (unsigned)(g1 * FIX), __ATOMIC_RELAXED, __HIP_MEMORY_SCOPE_WORKGROUP);
                    __hip_atomic_fetch_add(imp + tl * 65 + j0 + 9, (unsigned)(p1[4 * a + 3] * FIX), __ATOMIC_RELAXED, __HIP_MEMORY_SCOPE_WORKGROUP); }
                pv(oC, vp0 + sl, p0, p1);
            }
            sl = sl >= 2 * SLOTB ? 0 : sl + SLOTB;
        }
        NSA_WAIT_BAR(0);
    }
#pragma unroll 1
    for (int i = 0; i < 8; ++i) { const int t2 = 8 * wid + i; const unsigned sc = imp[t2 * 65 + lane];
        const bool forced = (lane == 0) || (lane == qt) || (lane == qt - 1);
        const unsigned score = forced ? 0xffffffffu : (lane <= qt ? sc + 1u : 0u);
        int rank = 0;
#pragma unroll 4
        for (int jj = 0; jj < 64; ++jj) { const unsigned sj = (unsigned)__builtin_amdgcn_readlane((int)score, jj); rank += ((sj > score) || (sj == score && jj < lane)) ? 1 : 0; }
        unsigned long long sel = __ballot(rank < 16); sel &= (qt == 63) ? ~0ull : ((1ull << (qt + 1)) - 1ull);
        if (lane == 0) { selm[2 * t2] = (unsigned)sel; selm[2 * t2 + 1] = (unsigned)(sel >> 32); } }
    NSA_WAIT_BAR(0);
    const unsigned long long mysel = (unsigned long long)selm[2 * tl] | ((unsigned long long)selm[2 * tl + 1] << 32);
    acc_o(res, oC, gateC);

    {
        const bf16* kb0 = A.PROJ + rowb * NPROJ_PAD + C_KSL + 64 * hkv + NSA_KOFF(NPROJ_PAD); const bf16* vb0 = A.PROJ + rowb * NPROJ_PAD + C_VSL + 64 * hkv + NSA_VOFF(NPROJ_PAD);
        float m = -1e30f, l = 0.f; f32x16 o[2]; o[0] = (f32x16){}; o[1] = (f32x16){};
        { NSA_DMA(kb0, vb0, 0); const int t1 = qt > 0 ? 1 : 0; NSA_DMA(kb0 + (long)t1 * 64 * NPROJ_PAD, vb0 + (long)t1 * 64 * NPROJ_PAD, SLOTB); }
        int sl = 0;
#pragma unroll 1
        for (int j = 0; j <= qt; ++j) {
            NSA_WAIT_BAR(2);
            { const int t2 = (j + 2 <= qt) ? j + 2 : qt; const int s2 = sl >= SLOTB ? sl - SLOTB : sl + 2 * SLOTB; NSA_DMA(kb0 + (long)t2 * 64 * NPROJ_PAD, vb0 + (long)t2 * 64 * NPROJ_PAD, s2); }
            f32x16 p0, p1; qkt(p0, p1, kp0 + sl, qr);
            const bool on = (mysel >> j) & 1ull;
            if (j + 3 <= qt) {
#pragma unroll
                for (int r = 0; r < 16; ++r) { p0[r] = on ? p0[r] + bfar : NEG; p1[r] = on ? p1[r] + bfar : NEG; }
            } else {
                const int dl = tq - 64 * j - 4 * hi;
#pragma unroll
                for (int r = 0; r < 16; ++r) { const int kvr = (r & 3) + 8 * (r >> 2); const int d0_ = dl - kvr, d1_ = d0_ - 32;
                    p0[r] = (on && d0_ >= 0) ? p0[r] + bX[64 + d0_] : NEG; p1[r] = (on && d1_ >= 0) ? p1[r] + bX[64 + d1_] : NEG; }
            }
            online(p0, p1, m, l, o);
            pv(o, vp0 + sl, p0, p1);
            sl = sl >= 2 * SLOTB ? 0 : sl + SLOTB;
        }
        NSA_WAIT_BAR(0);
        const float lt = swapsum(l); acc_o(res, o, lt > 0.f ? gateS / lt : 0.f);
    }
    {
        const bf16* kb0 = A.PROJ + rowb * NPROJ_PAD + C_KWN + 64 * hkv + NSA_KOFF(NPROJ_PAD); const bf16* vb0 = A.PROJ + rowb * NPROJ_PAD + C_VWN + 64 * hkv + NSA_VOFF(NPROJ_PAD);
        float m = -1e30f, l = 0.f; f32x16 o[2]; o[0] = (f32x16){}; o[1] = (f32x16){};
        const int jlo = qt > 8 ? qt - 8 : 0;
        { NSA_DMA(kb0 + (long)jlo * 64 * NPROJ_PAD, vb0 + (long)jlo * 64 * NPROJ_PAD, 0); const int t1 = jlo + 1 <= qt ? jlo + 1 : qt; NSA_DMA(kb0 + (long)t1 * 64 * NPROJ_PAD, vb0 + (long)t1 * 64 * NPROJ_PAD, SLOTB); }
        int sl = 0;
#pragma unroll 1
        for (int j = jlo; j <= qt; ++j) {
            NSA_WAIT_BAR(2);
            { const int t2 = (j + 2 <= qt) ? j + 2 : qt; const int s2 = sl >= SLOTB ? sl - SLOTB : sl + 2 * SLOTB; NSA_DMA(kb0 + (long)t2 * 64 * NPROJ_PAD, vb0 + (long)t2 * 64 * NPROJ_PAD, s2); }
            f32x16 p0, p1; qkt(p0, p1, kp0 + sl, qr);
            if (j + 3 <= qt) {
                const bool edge = (j + 8 == qt);
#pragma unroll
                for (int r = 0; r < 16; ++r) { const int kv0 = (r & 3) + 8 * (r >> 2) + 4 * hi;
                    p0[r] = (!edge || kv0 > tl) ? p0[r] + bfar : NEG; p1[r] = (!edge || kv0 + 32 > tl) ? p1[r] + bfar : NEG; }
            } else {
                const int dl = tq - 64 * j - 4 * hi;
#pragma unroll
                for (int r = 0; r < 16; ++r) { const int kvr = (r & 3) + 8 * (r >> 2); const int d0_ = dl - kvr, d1_ = d0_ - 32;
                    p0[r] = (d0_ >= 0) ? p0[r] + bX[64 + d0_] : NEG; p1[r] = (d1_ >= 0) ? p1[r] + bX[64 + d1_] : NEG; }
            }
            online(p0, p1, m, l, o);
            pv(o, vp0 + sl, p0, p1);
            sl = sl >= 2 * SLOTB ? 0 : sl + SLOTB;
        }
        NSA_WAIT_BAR(0);
        const float lt = swapsum(l); acc_o(res, o, lt > 0.f ? gateW / lt : 0.f);
    }
    {
        bf16* dst = A.Y + (size_t)(rowb + tq) * D + h8 * 64;
#pragma unroll
        for (int d0 = 0; d0 < 2; ++d0)
#pragma unroll
            for (int a = 0; a < 4; ++a) { u32x2 w; w.x = cvtpk(res[d0][4 * a], res[d0][4 * a + 1]); w.y = cvtpk(res[d0][4 * a + 2], res[d0][4 * a + 3]); *(u32x2*)(dst + 32 * d0 + 8 * a + 4 * hi) = w; }
    }
    asm volatile("s_waitcnt vmcnt(0)" ::: "memory");
#undef NSA_KOFF
#undef NSA_VOFF
#undef NSA_DMA
}
}

struct Args { const float* in[27]; float* out; unsigned char* ws; int ph_lo, ph_hi; };
__global__ void __launch_bounds__(NWAVES * 64, 2) hymba_fwd(Args args) {
    extern __shared__ __attribute__((aligned(16))) unsigned char lds_raw[];
    LAS unsigned char* lds = (LAS unsigned char*)lds_raw;
    volatile LAS unsigned* MISC = (volatile LAS unsigned*)(lds + MISC_OFF);
    const int tid = threadIdx.x, lane = tid & 63, wave = __builtin_amdgcn_readfirstlane(tid >> 6);
    const int G = gridDim.x; const int bx = blockIdx.x; const int vcu = (G % 8 == 0) ? (bx % 8) * (G / 8) + bx / 8 : bx;
    const int gw = vcu * NWAVES + wave, NGW = G * NWAVES;
    const long gtid = (long)vcu * 512 + tid, NGT = (long)G * 512;
    unsigned char* ws = args.ws;
    gu32* ctl = (gu32*)(ws + WS_CTL);
#define x_in ((const float*)args.in[0])
#define mem_in ((const float*)args.in[1])
#define rel_bias ((const float*)args.in[2])
#define g_mix_pre ((const float*)args.in[3])
#define w_in ((const float*)args.in[4])
#define cmp_pos_k ((const float*)args.in[5])
#define cmp_pos_v ((const float*)args.in[6])
#define cmp_w1_k ((const float*)args.in[7])
#define cmp_w2_k ((const float*)args.in[8])
#define cmp_w1_v ((const float*)args.in[9])
#define cmp_w2_v ((const float*)args.in[10])
#define conv_w ((const float*)args.in[11])
#define conv_b ((const float*)args.in[12])
#define gate_bias ((const float*)args.in[13])
#define mlstm_norm ((const float*)args.in[14])
#define w_out ((const float*)args.in[15])
#define g_mix_post ((const float*)args.in[16])
#define g_x_pre ((const float*)args.in[17])
#define g_mem ((const float*)args.in[18])
#define w_xq ((const float*)args.in[19])
#define w_xkv ((const float*)args.in[20])
#define w_xo ((const float*)args.in[21])
#define g_x_post ((const float*)args.in[22])
#define g_ffn_pre ((const float*)args.in[23])
#define w_gate_up ((const float*)args.in[24])
#define w_down ((const float*)args.in[25])
#define g_ffn_post ((const float*)args.in[26])
#define out_p (args.out)
#define Win_t ((bf16*)(ws + WS_WIN))
#define Wout_t ((bf16*)(ws + WS_WOUT))
#define Wxq_t ((bf16*)(ws + WS_WXQ))
#define Wxkv_t ((bf16*)(ws + WS_WXKV))
#define Wxo_t ((bf16*)(ws + WS_WXO))
#define Wgu_t ((bf16*)(ws + WS_WGU))
#define Wdn_t ((bf16*)(ws + WS_WDN))
#define Wc1_t ((bf16*)(ws + WS_WC1))
#define MEMN ((bf16*)(ws + WS_MEMN))
#define MEMK ((bf16*)(ws + WS_MEMK))
#define VT ((bf16*)(ws + WS_VT))
#define CKV ((bf16*)(ws + WS_CKV))
#define HID ((bf16*)(ws + WS_HID))
#define KCMP ((float*)(ws + WS_KCMP))
#define H ((bf16*)(ws + WS_H))
#define PROJ ((bf16*)(ws + WS_PROJ))
#define Y1 ((float*)(ws + WS_Y1))
#define ACT ((bf16*)(ws + WS_ACT))
#define YMIX ((bf16*)(ws + WS_YMIX))
#define QX ((bf16*)(ws + WS_QX))
#define Y2 ((float*)(ws + WS_Y2))
#define OX ((bf16*)(ws + WS_OX))
#define CU ((float*)(ws + WS_CU))
#define PB ((bf16*)(ws + WS_P))
#define MQK ((bf16*)(ws + WS_MQK))
#define Bc ((float*)(ws + WS_SMALL + SM_BC))
#define Gc ((float*)(ws + WS_SMALL + SM_GC))
#define PM ((float*)(ws + WS_SMALL + SM_PM))
#define NU ((float*)(ws + WS_SMALL + SM_NU))
#define MST ((float*)(ws + WS_SMALL + SM_MST))
#define DEC ((float*)(ws + WS_SMALL + SM_DEC))
#define CB1 ((float*)(ws + WS_CTL) + CW_CB1)
#define KCB ((bf16*)(ws + WS_SMALL + 6 * MiB))
#define VCB (KCB + (size_t)BATCH * 2 * 256 * 64)
    for (int u = tid; u < (LDS_BYTES - LDSCTL_OFF) / 4; u += NWAVES * 64) ((LAS unsigned*)(lds + LDSCTL_OFF))[u] = 0u;
    __syncthreads();
    XcdBarrier bar; bar.bar = (unsigned*)ctl + CW_BAR; bar.x = 0; bar.st = nullptr;
    if (MK_ONE_LAUNCH) bar = xcd_barrier_post((unsigned*)ctl + CW_BAR, MISC + 8);
    const int lo = args.ph_lo, hi = args.ph_hi;
#if defined(DBG_MASK)
#define IN(k) (((DBG_MASK >> (k)) & 1) && lo <= (k) && (k) < hi)
#elif defined(DBG_ONLY)
#define IN(k) ((k) == DBG_ONLY && lo <= (k) && (k) < hi)
#else
#define IN(k) (lo <= (k) && (k) < hi)
#endif
#define SEAM(k) do { if (MK_ONE_LAUNCH && IN(k) && IN((k) + 1)) xcd_barrier(bar); } while (0)

    if (IN(0)) {
        LAS float* scr = (LAS float*)(lds + wave * 16384);
        constexpr int I_IN = 16 * 89, I_SQ = 16 * 32, I_KV = 16 * 64, I_GU = 16 * 176, I_DN = 44 * 32, I_C1 = 32 * 8;
        constexpr int NITEMS = I_IN + 3 * I_SQ + I_KV + I_GU + I_DN + 2 * I_C1;
        for (int it = gw; it < NITEMS; it += NGW) {
            int r = it;
            if (r < I_IN) { const int kb = r / 89, nb = r % 89; transpose_item(w_in, NPROJ, Win_t, D, 64 * kb, 32 * nb, 32 * nb, scr, lane); continue; } r -= I_IN;
            if (r < I_SQ) { const int kb = r / 32, nb = r % 32; transpose_item(w_out, D, Wout_t, D, 64 * kb, 32 * nb, 32 * nb, scr, lane); continue; } r -= I_SQ;
            if (r < I_SQ) { const int kb = r / 32, nb = r % 32; transpose_item(w_xq, D, Wxq_t, D, 64 * kb, 32 * nb, 32 * nb, scr, lane); continue; } r -= I_SQ;
            if (r < I_SQ) { const int kb = r / 32, nb = r % 32; transpose_item(w_xo, D, Wxo_t, D, 64 * kb, 32 * nb, 32 * nb, scr, lane); continue; } r -= I_SQ;
            if (r < I_KV) { const int kb = r / 64, nb = r % 64; transpose_item(w_xkv, 2 * D, Wxkv_t, D, 64 * kb, 32 * nb, 32 * nb, scr, lane); continue; } r -= I_KV;
            if (r < I_GU) { const int kb = r / 176, nb = r % 176; const int n0 = 32 * nb; const int isu = n0 >= DFF ? 1 : 0, nn = n0 - isu * DFF;
                            transpose_item(w_gate_up, 2 * DFF, Wgu_t, D, 64 * kb, n0, 256 * (nn >> 7) + 128 * isu + (nn & 127), scr, lane); continue; } r -= I_GU;
            if (r < I_DN) { const int kb = r / 32, nb = r % 32; transpose_item(w_down, D, Wdn_t, DFF, 64 * kb, 32 * nb, 32 * nb, scr, lane); continue; } r -= I_DN;
            if (r < I_C1) { const int kb = r / 8, nb = r % 8; transpose_item(cmp_w1_k, 256, Wc1_t, 2048, 64 * kb, 32 * nb, 32 * nb, scr, lane); continue; } r -= I_C1;
            { const int kb = r / 8, nb = r % 8; transpose_item(cmp_w1_v, 256, Wc1_t + 256 * 2048, 2048, 64 * kb, 32 * nb, 32 * nb, scr, lane); }
        }
        for (long i = gtid; i < (long)(NPROJ_PAD - NPROJ) * D / 8; i += NGT) ((GAS v4u*)(Win_t + (size_t)NPROJ * D))[i] = (v4u){0u, 0u, 0u, 0u};
        for (int it = gw; it < 256; it += NGW) {
            const int kv = it >> 7, nc = (it >> 5) & 3, kc = it & 31; const float* pos = kv ? cmp_pos_v : cmp_pos_k; const float* w1 = kv ? cmp_w1_v : cmp_w1_k;
            float a = 0.f;
#pragma unroll 8
            for (int kk = 0; kk < 64; ++kk) a += pos[kc * 64 + kk] * w1[(size_t)(kc * 64 + kk) * 256 + nc * 64 + lane];
            atomicAdd(&CB1[kv * 256 + nc * 64 + lane], a);
        }
        for (int m = gw; m < T; m += NGW) rms_row_to_bf16(x_in + (size_t)m * D, g_mix_pre, H + (size_t)m * D, lane);
        for (int m = gw; m < BATCH * MEMT; m += NGW) rms_row_to_bf16(mem_in + (size_t)m * D, g_mem, MEMN + (size_t)m * D, lane);
    }
    SEAM(0);

    if (IN(1)) {
        { pg8::Gemm g{H, Win_t, D, D, D}; pg8::GridOrder S; S.init(T, NPROJ_PAD, D, D, G, bx); pg8::EpiBf16 E{PROJ, NPROJ_PAD, 1.0f, nsa::QSCALE, 512};
          pg8::gemm_phase<pg8::EpiBf16, pg8::GridOrder, true, true>(lds, g, S, E); }
        { pg8::Gemm g{MEMN, Wxkv_t, D, D, D}; pg8::GridOrder S; S.init(BATCH * MEMT, D, D, D, G, bx); pg8::EpiBf16 E{MEMK, D, 1.0f, 1.0f, 0};
          pg8::gemm_phase<pg8::EpiBf16, pg8::GridOrder, true, true>(lds, g, S, E); }
        { pg8::Gemm g{Wxkv_t + (size_t)D * D, MEMN, D, D, D}; pg8::GridOrder S; S.init(D, BATCH * MEMT, D, D, G, bx); pg8::EpiBf16 E{VT, BATCH * MEMT, 1.0f, 1.0f, 0};
          pg8::gemm_phase<pg8::EpiBf16, pg8::GridOrder, true, true>(lds, g, S, E); }
    }
    SEAM(1);

    if (IN(2)) {
        for (int bh = gw; bh < 32; bh += NGW) {
            const int b = bh >> 2, h = bh & 3; float m = 0.f; const float gbi = gate_bias[h], gbf = gate_bias[4 + h];
            if (lane == 0) MST[bh * 65] = 0.f;
            for (int k = 0; k < 64; ++k) {
                const size_t t = (size_t)b * SEQ + 64 * k + lane;
                const float ip = bf2f(PROJ[t * NPROJ_PAD + C_MI + h]) + gbi, fp = bf2f(PROJ[t * NPROJ_PAD + C_MF + h]) + gbf;
                const float lf = fminf(fp, 0.f) - log1pf(__expf(-fabsf(fp)));
                float bs = lf;
#pragma unroll
                for (int o = 1; o < 64; o <<= 1) { const float v = __shfl_up(bs, o); if (lane >= o) bs += v; }
                const float gg = ip - bs; float pmx = gg;
#pragma unroll
                for (int o = 1; o < 64; o <<= 1) { const float v = __shfl_up(pmx, o); if (lane >= o) pmx = fmaxf(pmx, v); }
                Bc[t * 4 + h] = bs; Gc[t * 4 + h] = gg; PM[t * 4 + h] = pmx;
                const float bL = __shfl(bs, 63), gmax = __shfl(pmx, 63);
                const float mn = fmaxf(bL + m, bL + gmax);
                if (lane == 0) { DEC[bh * 64 + k] = __expf(bL + m - mn); MST[bh * 65 + k + 1] = mn; }
                m = mn;
            }
        }
        for (long i = gtid; i < (long)T * 64; i += NGT) {
            const long t = i >> 6; const int c0 = (int)(i & 63) * 8, tt = (int)(t & (SEQ - 1));
            float a[8];
#pragma unroll
            for (int e = 0; e < 8; ++e) a[e] = conv_b[c0 + e];
#pragma unroll
            for (int j = 0; j < 4; ++j) { if (tt - 3 + j >= 0) { const v4u u = *(const GAS v4u*)(PROJ + (size_t)(t - 3 + j) * NPROJ_PAD + C_MQ + c0); const float* cw = conv_w + j * 512 + c0;
                a[0] += cw[0] * bflo(u.x); a[1] += cw[1] * bfhi(u.x); a[2] += cw[2] * bflo(u.y); a[3] += cw[3] * bfhi(u.y);
                a[4] += cw[4] * bflo(u.z); a[5] += cw[5] * bfhi(u.z); a[6] += cw[6] * bflo(u.w); a[7] += cw[7] * bfhi(u.w); } }
#pragma unroll
            for (int e = 0; e < 8; ++e) a[e] = a[e] * sigmoid_f(a[e]);
            v4u o; o.x = pk2(a[0], a[1]); o.y = pk2(a[2], a[3]); o.z = pk2(a[4], a[5]); o.w = pk2(a[6], a[7]);
            *(GAS v4u*)(MQK + (size_t)t * 512 + c0) = o;
        }
        for (long i = gtid; i < (long)2 * BATCH * 2 * SEQ * 8; i += NGT) {
            const int ch = (int)(i & 7); const long r = i >> 3; const int t = (int)(r & (SEQ - 1)); const int hkv = (int)((r >> 12) & 1), b = (int)((r >> 13) & 7), kv = (int)(r >> 16);
            *(GAS v4u*)(CKV + (size_t)r * 64 + ch * 8) = *(const GAS v4u*)(PROJ + ((size_t)b * SEQ + t) * NPROJ_PAD + C_KC + kv * 128 + hkv * 64 + ch * 8);
        }
    }
    SEAM(2);

    if (IN(3)) {
        { pg8::Gemm g{CKV, Wc1_t, 1024, 2048, 2048}; CmpOrder S{G, bx}; pg8::EpiSiluBias E{HID, 256, CB1};
          pg8::gemm_phase<pg8::EpiSiluBias, CmpOrder, true, true>(lds, g, S, E); }
        __syncthreads();
        LAS float* kwL = (LAS float*)lds; LAS float* vL = kwL + 64 * 64;
        for (int it = vcu; it < 2048; it += G) {
            const int bh = it >> 6, k = it & 63, b = bh >> 2, h = bh & 3; const size_t t0 = (size_t)b * SEQ + 64 * k;
            const float mnext = MST[bh * 65 + k + 1], bL = Bc[(t0 + 63) * 4 + h];
            for (int idx = tid; idx < 64 * 64; idx += 512) { const int s = idx >> 6, d = idx & 63;
                kwL[idx] = bf2f(MQK[(t0 + s) * 512 + 256 + h * 64 + d]) * 0.125f * __expf(bL + Gc[(t0 + s) * 4 + h] - mnext); }
            for (int idx = tid; idx < 64 * 128; idx += 512) { const int s = idx >> 7, vv = idx & 127; vL[idx] = bf2f(PROJ[(t0 + s) * NPROJ_PAD + C_MV + h * 128 + vv]); }
            __syncthreads();
            { const int d = tid >> 3, vg = tid & 7; f32x4 a[4] = {{0.f, 0.f, 0.f, 0.f}, {0.f, 0.f, 0.f, 0.f}, {0.f, 0.f, 0.f, 0.f}, {0.f, 0.f, 0.f, 0.f}};
              for (int s = 0; s < 64; ++s) { const float kwv = kwL[s * 64 + d]; const LAS f32x4* vp = (const LAS f32x4*)(vL + s * 128 + vg * 16);
#pragma unroll
                  for (int q = 0; q < 4; ++q) a[q] += vp[q] * kwv; }
              GAS f32x4* op = (GAS f32x4*)(CU + ((size_t)it * 64 + d) * 128 + vg * 16);
#pragma unroll
              for (int q = 0; q < 4; ++q) op[q] = a[q];
              if (tid < 64) { float un = 0.f; for (int s = 0; s < 64; ++s) un += kwL[s * 64 + tid]; NU[(size_t)it * 64 + tid] = un; } }
            __syncthreads();
        }
    }
    SEAM(3);

    if (IN(4)) {
        for (long i = gtid; i < (long)2 * 4096 * 64; i += NGT) {
            const int c = (int)(i & 63); const long r = i >> 6; const int kv = (int)(r >> 12); const float* w2 = kv ? cmp_w2_v : cmp_w2_k; const bf16* hp = HID + (size_t)r * 256;
            float a = 0.f;
#pragma unroll 8
            for (int n = 0; n < 256; ++n) a += bf2f(hp[n]) * w2[n * 64 + c];
            KCMP[i] = a; KCB[i] = (bf16)((((int)r & 255) == 255) ? 0u : f2bf(a));
        }
        for (long i = gtid; i < (long)32 * 8192 + 32 * 64; i += NGT) {
            if (i < (long)32 * 8192) { const int bh = (int)(i >> 13), e = (int)(i & 8191); float c = 0.f;
                for (int k = 0; k < 64; ++k) { float* p = CU + ((size_t)(bh * 64 + k)) * 8192 + e; const float u = *p; *p = c; c = DEC[bh * 64 + k] * c + u; } }
            else { const long j = i - (long)32 * 8192; const int bh = (int)(j >> 6), e = (int)(j & 63); float c = 0.f;
                for (int k = 0; k < 64; ++k) { float* p = NU + ((size_t)(bh * 64 + k)) * 64 + e; const float u = *p; *p = c; c = DEC[bh * 64 + k] * c + u; } }
        }
    }
    SEAM(4);

    if (IN(5)) {
        LAS float* bXt = (LAS float*)(lds + nsa::L_BIAS);
        for (int idx = tid; idx < 8 * 320; idx += 512) { const int hh = idx / 320; int d = idx % 320 - 64; d = d < 0 ? 0 : (d > 128 ? 128 : d); bXt[idx] = rel_bias[hh * 32 + kBucket[d]] * nsa::LOG2E; }
        __syncthreads();
        const nsa::Tensors NT{PROJ, KCB, VCB, YMIX};
        for (int u = vcu; u < 1024; u += G) { const int v = u & 255, i = u >> 8, bh = v >> 4, s = v & 15; const int qt = (i == 0) ? s : (i == 1) ? 31 - s : (i == 2) ? 32 + s : 63 - s;
            nsa::unit(NT, bh >> 1, bh & 1, qt, lds); }
        __syncthreads();
    }
    SEAM(5);

    if (IN(6)) {
        {
            LAS float* qL = (LAS float*)lds; LAS float* kL = qL + 64 * 65; LAS float* vL = kL + 64 * 65; LAS float* CL = vL + 64 * 128; LAS float* SL = CL + 64 * 128;
            LAS float* nL = SL + 64 * 65; LAS float* bLs = nL + 64; LAS float* GLs = bLs + 64; LAS float* mtL = GLs + 64; LAS float* aL = mtL + 64;
            for (int it = vcu; it < 2048; it += G) {
                const int bh = it >> 6, k = it & 63, b = bh >> 2, h = bh & 3; const size_t t0 = (size_t)b * SEQ + 64 * k;
                for (int idx = tid; idx < 64 * 64; idx += 512) { const int s = idx >> 6, d = idx & 63;
                    qL[s * 65 + d] = bf2f(MQK[(t0 + s) * 512 + h * 64 + d]); kL[s * 65 + d] = bf2f(MQK[(t0 + s) * 512 + 256 + h * 64 + d]) * 0.125f; }
                for (int idx = tid; idx < 64 * 128; idx += 512) { const int s = idx >> 7, vv = idx & 127; vL[idx] = bf2f(PROJ[(t0 + s) * NPROJ_PAD + C_MV + h * 128 + vv]); CL[idx] = CU[(size_t)it * 8192 + idx]; }
                if (tid < 64) { const float bt = Bc[(t0 + tid) * 4 + h], pm = PM[(t0 + tid) * 4 + h], mk = MST[bh * 65 + k]; const float mt = fmaxf(bt + mk, bt + pm);
                    mtL[tid] = mt; aL[tid] = __expf(bt + mk - mt); bLs[tid] = bt; GLs[tid] = Gc[(t0 + tid) * 4 + h]; nL[tid] = NU[(size_t)it * 64 + tid]; }
                __syncthreads();
                { const int t = tid >> 3, sg = tid & 7; float dots[8];
#pragma unroll
                  for (int j = 0; j < 8; ++j) dots[j] = 0.f;
                  for (int d = 0; d < 64; ++d) { const float qv = qL[t * 65 + d];
#pragma unroll
                      for (int j = 0; j < 8; ++j) dots[j] += qv * kL[(sg * 8 + j) * 65 + d]; }
                  const float bt = bLs[t], mt = mtL[t];
#pragma unroll
                  for (int j = 0; j < 8; ++j) { const int s = sg * 8 + j; SL[t * 65 + s] = (s <= t) ? dots[j] * __expf(bt + GLs[s] - mt) : 0.f; } }
                __syncthreads();
                { const int t = tid >> 3, vg = tid & 7; f32x4 num[4] = {{0.f, 0.f, 0.f, 0.f}, {0.f, 0.f, 0.f, 0.f}, {0.f, 0.f, 0.f, 0.f}, {0.f, 0.f, 0.f, 0.f}}; float den = 0.f;
                  for (int s = 0; s < 64; ++s) { const float sv = SL[t * 65 + s]; den += sv; const LAS f32x4* vp = (const LAS f32x4*)(vL + s * 128 + vg * 16);
#pragma unroll
                      for (int q = 0; q < 4; ++q) num[q] += vp[q] * sv; }
                  const float a = aL[t]; float qn = 0.f;
                  for (int d = 0; d < 64; ++d) { const float qa = qL[t * 65 + d] * a; qn += qa * nL[d]; const LAS f32x4* cp = (const LAS f32x4*)(CL + d * 128 + vg * 16);
#pragma unroll
                      for (int q = 0; q < 4; ++q) num[q] += cp[q] * qa; }
                  den += qn;
                  const float dn = fmaxf(fabsf(den), __expf(-mtL[t])), inv = 1.0f / dn; float ss = 0.f;
#pragma unroll
                  for (int q = 0; q < 4; ++q) { num[q] = num[q] * inv; ss += (num[q].x * num[q].x + num[q].y * num[q].y) + (num[q].z * num[q].z + num[q].w * num[q].w); }
                  ss += __shfl_xor(ss, 1); ss += __shfl_xor(ss, 2); ss += __shfl_xor(ss, 4);
                  const float rstd = 1.0f / sqrtf(ss * (1.0f / 128.0f) + EPS);
                  const int c0 = h * 128 + vg * 16; const bf16* mo = PROJ + (t0 + t) * NPROJ_PAD + C_MO + c0; const float* gn = mlstm_norm + c0;
                  unsigned w[8];
#pragma unroll
                  for (int q = 0; q < 4; ++q) { const float y0 = sigmoid_f(bf2f(mo[q * 4 + 0])) * (num[q].x * rstd * gn[q * 4 + 0]), y1 = sigmoid_f(bf2f(mo[q * 4 + 1])) * (num[q].y * rstd * gn[q * 4 + 1]);
                      const float y2 = sigmoid_f(bf2f(mo[q * 4 + 2])) * (num[q].z * rstd * gn[q * 4 + 2]), y3 = sigmoid_f(bf2f(mo[q * 4 + 3])) * (num[q].w * rstd * gn[q * 4 + 3]);
                      w[q * 2] = pk2(y0, y1); w[q * 2 + 1] = pk2(y2, y3); }
                  GAS v4u* op = (GAS v4u*)(YMIX + (t0 + t) * D + 512 + c0); op[0] = (v4u){w[0], w[1], w[2], w[3]}; op[1] = (v4u){w[4], w[5], w[6], w[7]}; }
                __syncthreads();
            }
        }
    }
    SEAM(6);

    if (IN(7)) { pg8::Gemm g{YMIX, Wout_t, D, D, D}; pg8::GridOrder S; S.init(T, D, D, D, G, bx); pg8::EpiF32 E{Y1, D};
        pg8::gemm_phase<pg8::EpiF32, pg8::GridOrder, true, true>(lds, g, S, E); }
    SEAM(7);
    if (IN(8)) { for (int m = gw; m < T; m += NGW) resnorm_row(Y1 + (size_t)m * D, x_in + (size_t)m * D, g_mix_post, out_p + (size_t)m * D, g_x_pre, H + (size_t)m * D, lane); }
    SEAM(8);
    if (IN(9)) { pg8::Gemm g{H, Wxq_t, D, D, D}; pg8::GridOrder S; S.init(T, D, D, D, G, bx); pg8::EpiBf16 E{QX, D, 0.0625f, 1.0f, 0};
        pg8::gemm_phase<pg8::EpiBf16, pg8::GridOrder, true, true>(lds, g, S, E); }
    SEAM(9);
    if (IN(10)) { pg8::Gemm g{QX, MEMK, D, D, 256}; XaSOrder S{G, bx}; pg8::EpiF32 E{Y1, D};
        pg8::gemm_phase<pg8::EpiF32, XaSOrder, true, true>(lds, g, S, E); }
    SEAM(10);
    if (IN(11)) {
        for (int m = gw; m < T; m += NGW) {
            const GAS f32x4* sr = (const GAS f32x4*)(Y1 + (size_t)m * D) + lane; GAS unsigned long long* o8 = (GAS unsigned long long*)(PB + (size_t)m * D) + lane;
#pragma unroll
            for (int h = 0; h < 4; ++h) { const f32x4 v = sr[64 * h]; const float mx = wave_max(fmaxf(fmaxf(v.x, v.y), fmaxf(v.z, v.w)));
                f32x4 p; p.x = __expf(v.x - mx); p.y = __expf(v.y - mx); p.z = __expf(v.z - mx); p.w = __expf(v.w - mx);
                const float inv = 1.0f / wave_sum((p.x + p.y) + (p.z + p.w));
                o8[64 * h] = (unsigned long long)pk2(p.x * inv, p.y * inv) | ((unsigned long long)pk2(p.z * inv, p.w * inv) << 32); }
        }
    }
    SEAM(11);
    if (IN(12)) { pg8::Gemm g{PB, VT, D, BATCH * MEMT, 256}; XaPVOrder S{G, bx}; pg8::EpiBf16 E{OX, D, 1.0f, 1.0f, 0};
        pg8::gemm_phase<pg8::EpiBf16, XaPVOrder, true, true>(lds, g, S, E); }
    SEAM(12);
    if (IN(13)) { pg8::Gemm g{OX, Wxo_t, D, D, D}; pg8::GridOrder S; S.init(T, D, D, D, G, bx); pg8::EpiF32 E{Y1, D};
        pg8::gemm_phase<pg8::EpiF32, pg8::GridOrder, true, true>(lds, g, S, E); }
    SEAM(13);
    if (IN(14)) { for (int m = gw; m < T; m += NGW) resnorm_row(Y1 + (size_t)m * D, out_p + (size_t)m * D, g_x_post, out_p + (size_t)m * D, g_ffn_pre, H + (size_t)m * D, lane); }
    SEAM(14);
    if (IN(15)) { pg8::Gemm g{H, Wgu_t, D, D, D}; pg8::GridOrder S; S.init(T, 2 * DFF, D, D, G, bx); pg8::EpiSwiglu E{ACT, DFF};
        pg8::gemm_phase<pg8::EpiSwiglu, pg8::GridOrder, true, true>(lds, g, S, E); }
    SEAM(15);
    if (IN(16)) { pg8::Gemm g{ACT, Wdn_t, DFF, DFF, DFF}; pg8::GridOrder S; S.init(T, D, DFF, DFF, G, bx); pg8::EpiF32 E{Y2, D};
        pg8::gemm_phase<pg8::EpiF32, pg8::GridOrder, true, true>(lds, g, S, E); }
    SEAM(16);
    if (IN(17)) { for (int m = gw; m < T; m += NGW) resnorm_row(Y2 + (size_t)m * D, out_p + (size_t)m * D, g_ffn_post, out_p + (size_t)m * D, nullptr, nullptr, lane); }
#undef IN
#undef SEAM
}

extern "C" void kernel_launch(void* const* d_in, const int* in_sizes, int n_in, void* d_out, int out_size, void* d_ws, size_t ws_size, hipStream_t stream) {
    static int grid = 0;
    if (grid == 0) {
        if (n_in != 27 || in_sizes[0] != T * D || out_size != T * D || ws_size < WS_END) { fprintf(stderr, "kernel_launch: unexpected shapes (n_in %d, in0 %d, out %d, ws %zu); nothing launched\n", n_in, n_in > 0 ? in_sizes[0] : -1, out_size, ws_size); grid = -1; return; }
        int dev = 0, cus = 0, per_cu = 0;
        if (hipGetDevice(&dev) != hipSuccess || hipDeviceGetAttribute(&cus, hipDeviceAttributeMultiprocessorCount, dev) != hipSuccess) { grid = -1; return; }
        if (hipFuncSetAttribute((const void*)hymba_fwd, hipFuncAttributeMaxDynamicSharedMemorySize, LDS_BYTES) != hipSuccess) { fprintf(stderr, "kernel_launch: hipFuncSetAttribute failed\n"); grid = -1; return; }
        if (hipOccupancyMaxActiveBlocksPerMultiprocessor(&per_cu, (const void*)hymba_fwd, NWAVES * 64, LDS_BYTES) != hipSuccess || per_cu < 1) fprintf(stderr, "kernel_launch: occupancy query reports %d workgroups per CU\n", per_cu);
        (void)hipGetLastError();
        grid = cus;
    }
    if (grid < 0) return;
    if (hipMemsetAsync((char*)d_ws + WS_CTL, 0, CTL_ZERO_BYTES, stream) != hipSuccess) return;
    Args a{};
    for (int i = 0; i < 27; ++i) a.in[i] = (const float*)d_in[i];
    a.out = (float*)d_out; a.ws = (unsigned char*)d_ws;
#if MK_ONE_LAUNCH
    a.ph_lo = 0; a.ph_hi = NPHASE;
    hipLaunchKernelGGL(hymba_fwd, dim3(grid), dim3(NWAVES * 64), LDS_BYTES, stream, a);
#else
    for (int p = 0; p < NPHASE; ++p) { a.ph_lo = p; a.ph_hi = p + 1; hipLaunchKernelGGL(hymba_fwd, dim3(grid), dim3(NWAVES * 64), LDS_BYTES, stream, a); }
#endif
}
```

```cpp
#include <hip/hip_runtime.h>
#include <cstdio>
#include <cstdint>

#ifndef MK_ONE_LAUNCH
#define MK_ONE_LAUNCH 1
#endif

namespace pg8 {
#define PG8_LAS __attribute__((address_space(3)))
typedef unsigned short bf16_t;
typedef short bf16x8 __attribute__((ext_vector_type(8)));
typedef float f32x4 __attribute__((ext_vector_type(4)));
typedef unsigned u32x4 __attribute__((ext_vector_type(4)));
constexpr int BM = 256, BK = 64, HALF = 128, HTB = HALF * BK * 2, STAGE_BYTES = 8 * HTB, NXCD = 8, WGM = 8;

__host__ __device__ __forceinline__ int lds_byte(int r, int c) { const int st = (r >> 4) * 2 + (c >> 5), rr = r & 15, cc = c & 31, ob = rr * 64 + cc * 2; return st * 1024 + (ob ^ (((ob >> 9) & 1) << 5)); }
__host__ __device__ __forceinline__ void stage_rc(int b, int& R, int& C) { const int st = b / 1024, sb = b % 1024, swz = sb ^ (((sb >> 9) & 1) << 5); R = (st >> 1) * 16 + swz / 64; C = (st & 1) * 32 + (swz % 64) / 2; }
__host__ __device__ __forceinline__ int perm32(int rho) { const int n = rho >> 4, i = rho & 15; return 8 * (i >> 2) + 4 * n + (i & 3); }

struct Unit { int orow, ocol, bz; };
struct Gemm { const bf16_t* A; const bf16_t* Bt; int lda, ldb, K; };

struct GridOrder {
    int nM, nN, nwg, G, c, lda, ldb;
    __device__ void init(int M, int N, int lda_, int ldb_, int G_, int c_) { nM = M / BM; nN = N / BM; nwg = nM * nN; G = G_; c = c_; lda = lda_; ldb = ldb_; }
    __device__ bool next(int i, Unit& u) const {
        const long L = (long)i * G + c; if (L >= nwg) return false;
        int wgid = (int)L; { const int q = nwg / NXCD, r = nwg % NXCD, xcd = wgid % NXCD, off = wgid / NXCD; wgid = (xcd < r ? xcd * (q + 1) : r * (q + 1) + (xcd - r) * q) + off; }
        const int nig = WGM * nN, gid = wgid / nig, fm = gid * WGM, gsz = (nM - fm) < WGM ? (nM - fm) : WGM;
        const int pm = fm + ((wgid % nig) % gsz), pn = (wgid % nig) / gsz; u.bz = 0; u.orow = pm * BM; u.ocol = pn * BM; return true;
    }
    __device__ __forceinline__ long offA(const Unit& u) const { return (long)u.orow * lda; }
    __device__ __forceinline__ long offB(const Unit& u) const { return (long)u.ocol * ldb; }
};

__device__ __forceinline__ unsigned cvt_pk_bf16(float lo, float hi) { unsigned r; asm volatile("v_cvt_pk_bf16_f32 %0, %1, %2" : "=v"(r) : "v"(lo), "v"(hi)); return r; }
__device__ __forceinline__ float silu_f(float v) { return v / (1.0f + __expf(-v)); }

struct EpiBf16 {
    static constexpr bool PERM = true;
    bf16_t* O; int ldc; float scale; float scale0; int ncol0;
    __device__ __forceinline__ void operator()(f32x4 (&acc)[2][2][4][2], const Unit& u, int wr, int wc, int fr, int fq) const {
        const int row0 = u.orow + wr * 64 + fr, col0 = u.ocol + wc * 32 + 8 * fq; const float scale = (u.ocol < ncol0) ? this->scale0 : this->scale;
#pragma unroll
        for (int ai = 0; ai < 2; ++ai)
#pragma unroll
            for (int m = 0; m < 4; ++m) { bf16_t* rowp = O + (size_t)(row0 + ai * HALF + m * 16) * ldc + col0;
#pragma unroll
                for (int bj = 0; bj < 2; ++bj) { const f32x4 v0 = acc[ai][bj][m][0] * scale, v1 = acc[ai][bj][m][1] * scale;
                    u32x4 w; w.x = cvt_pk_bf16(v0[0], v0[1]); w.y = cvt_pk_bf16(v0[2], v0[3]); w.z = cvt_pk_bf16(v1[0], v1[1]); w.w = cvt_pk_bf16(v1[2], v1[3]);
                    *(u32x4*)(rowp + bj * HALF) = w; } }
    }
};
struct EpiF32 {
    static constexpr bool PERM = false;
    float* O; int ldc;
    __device__ __forceinline__ void operator()(f32x4 (&acc)[2][2][4][2], const Unit& u, int wr, int wc, int fr, int fq) const {
        const int row0 = u.orow + wr * 64 + fr, col0 = u.ocol + wc * 32 + 4 * fq;
#pragma unroll
        for (int ai = 0; ai < 2; ++ai)
#pragma unroll
            for (int m = 0; m < 4; ++m) { float* rowp = O + (size_t)(row0 + ai * HALF + m * 16) * ldc + col0;
#pragma unroll
                for (int bj = 0; bj < 2; ++bj)
#pragma unroll
                    for (int n = 0; n < 2; ++n) *(f32x4*)(rowp + bj * HALF + n * 16) = acc[ai][bj][m][n]; }
    }
};
struct EpiSiluBias {
    static constexpr bool PERM = true;
    bf16_t* O; int ldc; const float* bias;
    __device__ __forceinline__ void operator()(f32x4 (&acc)[2][2][4][2], const Unit& u, int wr, int wc, int fr, int fq) const {
        const int row0 = u.orow + wr * 64 + fr, col0 = u.ocol + wc * 32 + 8 * fq; const float* bp = bias + u.bz * 256 + wc * 32 + 8 * fq;
        f32x4 bv[2][2];
#pragma unroll
        for (int bj = 0; bj < 2; ++bj)
#pragma unroll
            for (int n = 0; n < 2; ++n) bv[bj][n] = *(const f32x4*)(bp + bj * HALF + 4 * n);
#pragma unroll
        for (int ai = 0; ai < 2; ++ai)
#pragma unroll
            for (int m = 0; m < 4; ++m) { bf16_t* rowp = O + (size_t)(row0 + ai * HALF + m * 16) * ldc + col0;
#pragma unroll
                for (int bj = 0; bj < 2; ++bj) { f32x4 v0 = acc[ai][bj][m][0] + bv[bj][0], v1 = acc[ai][bj][m][1] + bv[bj][1];
#pragma unroll
                    for (int i = 0; i < 4; ++i) { v0[i] = silu_f(v0[i]); v1[i] = silu_f(v1[i]); }
                    u32x4 w; w.x = cvt_pk_bf16(v0[0], v0[1]); w.y = cvt_pk_bf16(v0[2], v0[3]); w.z = cvt_pk_bf16(v1[0], v1[1]); w.w = cvt_pk_bf16(v1[2], v1[3]);
                    *(u32x4*)(rowp + bj * HALF) = w; } }
    }
};
struct EpiSwiglu {
    static constexpr bool PERM = true;
    bf16_t* O; int ldc;
    __device__ __forceinline__ void operator()(f32x4 (&acc)[2][2][4][2], const Unit& u, int wr, int wc, int fr, int fq) const {
        const int row0 = u.orow + wr * 64 + fr, col0 = (u.ocol >> 1) + wc * 32 + 8 * fq;
#pragma unroll
        for (int ai = 0; ai < 2; ++ai)
#pragma unroll
            for (int m = 0; m < 4; ++m) { bf16_t* rowp = O + (size_t)(row0 + ai * HALF + m * 16) * ldc + col0;
                f32x4 v0, v1;
#pragma unroll
                for (int i = 0; i < 4; ++i) { v0[i] = silu_f(acc[ai][0][m][0][i]) * acc[ai][1][m][0][i]; v1[i] = silu_f(acc[ai][0][m][1][i]) * acc[ai][1][m][1][i]; }
                u32x4 w; w.x = cvt_pk_bf16(v0[0], v0[1]); w.y = cvt_pk_bf16(v0[2], v0[3]); w.z = cvt_pk_bf16(v1[0], v1[1]); w.w = cvt_pk_bf16(v1[2], v1[3]);
                *(u32x4*)rowp = w; }
    }
};
template <class Epi, class Sched, bool ALIGN_EPI, bool SP2>
__device__ __forceinline__ void gemm_phase(PG8_LAS unsigned char* lds, const Gemm g, const Sched& S, const Epi& E) {
    int tid_ = threadIdx.x; asm volatile("" : "+v"(tid_));
    const int tid = tid_, wid = __builtin_amdgcn_readfirstlane(tid >> 6), lane = tid & 63, wr = wid >> 2, wc = wid & 3, fr = lane & 15, fq = lane >> 4;
    const int K = g.K, nt = K / BK;
    unsigned voffA[2], voffB[2];
#pragma unroll
    for (int i = 0; i < 2; ++i) { int R, C; stage_rc(tid * 16 + i * 8192, R, C); const int Rb = Epi::PERM ? ((R & ~31) + perm32(R & 31)) : R;
        voffA[i] = (unsigned)(R * g.lda + C) * 2u; voffB[i] = (unsigned)(Rb * g.ldb + C) * 2u; }
    const size_t kstep = (size_t)(BK * 2);
    const size_t hstepA = (size_t)HALF * g.lda * 2, hstepB = (size_t)HALF * g.ldb * 2;
    const unsigned ldsw = (unsigned)wid * 1024u;
    const int aoff = lds_byte(wr * 64 + fr, fq * 8), boff = lds_byte(wc * 32 + fr, fq * 8);
#define PG8_SA(b, h) (((b) * 2 + (h)) * HTB)
#define PG8_SB(b, h) ((4 + (b) * 2 + (h)) * HTB)
#define PG8_STAGE(bufoff, gbase, voff) do { _Pragma("unroll") for (int _i = 0; _i < 2; ++_i) \
        __builtin_amdgcn_global_load_lds((const unsigned*)((const char*)(gbase) + (voff)[_i]), (PG8_LAS unsigned*)(lds + (bufoff) + ldsw + _i * 8192), 16, 0, 0); } while (0)
#define PG8_LDA(dst, b, h) do { _Pragma("unroll") for (int m = 0; m < 4; ++m) _Pragma("unroll") for (int k = 0; k < 2; ++k) dst[m][k] = *(const PG8_LAS bf16x8*)(lds + PG8_SA(b, h) + aoff + m * 2048 + k * 1024); } while (0)
#define PG8_LDB(dst, b, h) do { _Pragma("unroll") for (int n = 0; n < 2; ++n) _Pragma("unroll") for (int k = 0; k < 2; ++k) dst[n][k] = *(const PG8_LAS bf16x8*)(lds + PG8_SB(b, h) + boff + n * 2048 + k * 1024); } while (0)
#define PG8_MMA(ai, bj, At, Bt) do { __builtin_amdgcn_s_setprio(1); _Pragma("unroll") for (int m = 0; m < 4; ++m) _Pragma("unroll") for (int n = 0; n < 2; ++n) _Pragma("unroll") for (int k = 0; k < 2; ++k) \
        acc[ai][bj][m][n] = __builtin_amdgcn_mfma_f32_16x16x32_bf16(Bt[n][k], At[m][k], acc[ai][bj][m][n], 0, 0, 0); __builtin_amdgcn_s_setprio(0); } while (0)
#define PG8_WAIT_V(n) asm volatile("s_waitcnt vmcnt(" #n ")" ::: "memory")
#define PG8_WAIT_L(n) asm volatile("s_waitcnt lgkmcnt(" #n ")" ::: "memory")
#define PG8_BAR __builtin_amdgcn_s_barrier()
#define PG8_SCHED __builtin_amdgcn_sched_barrier(0)
    Unit cur, nxt; int ui = 0;
    if (!S.next(0, cur)) return;
    f32x4 acc[2][2][4][2];
#pragma unroll
    for (int a = 0; a < 2; ++a)
#pragma unroll
        for (int b = 0; b < 2; ++b)
#pragma unroll
            for (int m = 0; m < 4; ++m)
#pragma unroll
                for (int n = 0; n < 2; ++n) acc[a][b][m][n] = (f32x4){0.f, 0.f, 0.f, 0.f};
    bf16x8 At[4][2], B0[2][2], B1[2][2];
    const char* cA = (const char*)g.A + (size_t)S.offA(cur) * 2; const char* cB = (const char*)g.Bt + (size_t)S.offB(cur) * 2;
    if constexpr (SP2) {
        PG8_STAGE(PG8_SB(0, 0), cB, voffB); PG8_STAGE(PG8_SB(0, 1), cB + hstepB, voffB); PG8_STAGE(PG8_SA(0, 0), cA, voffA); PG8_STAGE(PG8_SA(0, 1), cA + hstepA, voffA);
        if (wr == 1) PG8_BAR;
        PG8_WAIT_V(2); PG8_BAR;
        PG8_STAGE(PG8_SB(1, 0), cB + kstep, voffB); PG8_STAGE(PG8_SA(1, 0), cA + kstep, voffA); PG8_STAGE(PG8_SB(1, 1), cB + hstepB + kstep, voffB);
        PG8_WAIT_V(6); PG8_BAR;
    } else {
        PG8_STAGE(PG8_SB(0, 0), cB, voffB); PG8_STAGE(PG8_SA(0, 0), cA, voffA); PG8_STAGE(PG8_SB(0, 1), cB + hstepB, voffB); PG8_STAGE(PG8_SA(0, 1), cA + hstepA, voffA);
        if (wr == 1) PG8_BAR;
        PG8_WAIT_V(4); PG8_BAR;
        PG8_STAGE(PG8_SB(1, 0), cB + kstep, voffB); PG8_STAGE(PG8_SA(1, 0), cA + kstep, voffA); PG8_STAGE(PG8_SB(1, 1), cB + hstepB + kstep, voffB);
        PG8_WAIT_V(6); PG8_BAR;
    }
    for (;;) {
        const bool has_next = S.next(ui + 1, nxt);
        const char* nA = has_next ? (const char*)g.A + (size_t)S.offA(nxt) * 2 : cA; const char* nB = has_next ? (const char*)g.Bt + (size_t)S.offB(nxt) * 2 : cB;
#pragma unroll 1
        for (int t = 0; t < nt; t += 2) {
            const bool last = (t == nt - 2);
            const char* a1 = cA + (size_t)(t + 1) * kstep;
            const char* a2 = last ? nA : cA + (size_t)(t + 2) * kstep; const char* b2 = last ? nB : cB + (size_t)(t + 2) * kstep;
            const char* a3 = a2 + kstep; const char* b3 = b2 + kstep;
            if constexpr (SP2) {
            PG8_LDB(B0, 0, 0); PG8_LDB(B1, 0, 1); PG8_SCHED; PG8_LDA(At, 0, 0); PG8_STAGE(PG8_SA(1, 1), a1 + hstepA, voffA);
            PG8_WAIT_V(8); PG8_WAIT_L(0); PG8_BAR; PG8_MMA(0, 0, At, B0); PG8_MMA(0, 1, At, B1); PG8_BAR; PG8_SCHED;
            PG8_LDA(At, 0, 1); PG8_STAGE(PG8_SB(0, 0), b2, voffB); PG8_STAGE(PG8_SB(0, 1), b2 + hstepB, voffB); PG8_STAGE(PG8_SA(0, 0), a2, voffA);
            PG8_WAIT_V(8); PG8_WAIT_L(0); PG8_BAR; PG8_MMA(1, 0, At, B0); PG8_MMA(1, 1, At, B1); PG8_BAR; PG8_SCHED;
            PG8_LDB(B0, 1, 0); PG8_LDB(B1, 1, 1); PG8_SCHED; PG8_LDA(At, 1, 0); PG8_STAGE(PG8_SA(0, 1), a2 + hstepA, voffA);
            PG8_WAIT_V(8); PG8_WAIT_L(0); PG8_BAR; PG8_MMA(0, 0, At, B0); PG8_MMA(0, 1, At, B1); PG8_BAR; PG8_SCHED;
            PG8_LDA(At, 1, 1); PG8_STAGE(PG8_SB(1, 0), b3, voffB); PG8_STAGE(PG8_SB(1, 1), b3 + hstepB, voffB); PG8_STAGE(PG8_SA(1, 0), a3, voffA);
            PG8_WAIT_V(8); PG8_WAIT_L(0); PG8_BAR; PG8_MMA(1, 0, At, B0); PG8_MMA(1, 1, At, B1); PG8_BAR; PG8_SCHED;
            } else {
            PG8_LDB(B0, 0, 0); PG8_SCHED; PG8_LDA(At, 0, 0); PG8_STAGE(PG8_SA(1, 1), a1 + hstepA, voffA);
            PG8_WAIT_L(8); PG8_BAR; PG8_WAIT_L(0); PG8_MMA(0, 0, At, B0); PG8_BAR; PG8_SCHED;
            PG8_LDB(B1, 0, 1); PG8_STAGE(PG8_SB(0, 0), b2, voffB);
            PG8_BAR; PG8_WAIT_L(0); PG8_MMA(0, 1, At, B1); PG8_BAR;
            PG8_LDA(At, 0, 1); PG8_STAGE(PG8_SA(0, 0), a2, voffA);
            PG8_BAR; PG8_WAIT_L(0); PG8_MMA(1, 0, At, B0); PG8_BAR; PG8_SCHED;
            PG8_STAGE(PG8_SB(0, 1), b2 + hstepB, voffB);
            PG8_WAIT_V(6); PG8_BAR; PG8_MMA(1, 1, At, B1); PG8_BAR;
            PG8_LDB(B0, 1, 0); PG8_SCHED; PG8_LDA(At, 1, 0); PG8_STAGE(PG8_SA(0, 1), a2 + hstepA, voffA);
            PG8_WAIT_L(8); PG8_BAR; PG8_WAIT_L(0); PG8_MMA(0, 0, At, B0); PG8_BAR; PG8_SCHED;
            PG8_LDB(B1, 1, 1); PG8_STAGE(PG8_SB(1, 0), b3, voffB);
            PG8_BAR; PG8_WAIT_L(0); PG8_MMA(0, 1, At, B1); PG8_BAR;
            PG8_LDA(At, 1, 1); PG8_STAGE(PG8_SA(1, 0), a3, voffA);
            PG8_BAR; PG8_WAIT_L(0); PG8_MMA(1, 0, At, B0); PG8_BAR; PG8_SCHED;
            PG8_STAGE(PG8_SB(1, 1), b3 + hstepB, voffB);
            PG8_WAIT_V(6); PG8_BAR; PG8_MMA(1, 1, At, B1); PG8_BAR;
            }
        }
        if constexpr (ALIGN_EPI) { if (wr == 0) PG8_BAR; }
        E(acc, cur, wr, wc, fr, fq);
        if (!has_next) break;
#pragma unroll
        for (int a = 0; a < 2; ++a)
#pragma unroll
            for (int b = 0; b < 2; ++b)
#pragma unroll
                for (int m = 0; m < 4; ++m)
#pragma unroll
                    for (int n = 0; n < 2; ++n) acc[a][b][m][n] = (f32x4){0.f, 0.f, 0.f, 0.f};
        cur = nxt; cA = nA; cB = nB; ++ui;
        if constexpr (ALIGN_EPI) { if (wr == 1) PG8_BAR; }
    }
    PG8_WAIT_V(0);
    if constexpr (!ALIGN_EPI) { if (wr == 0) PG8_BAR; }
    PG8_BAR;
#undef PG8_SA
#undef PG8_SB
#undef PG8_STAGE
#undef PG8_LDA
#undef PG8_LDB
#undef PG8_MMA
#undef PG8_WAIT_V
#undef PG8_WAIT_L
#undef PG8_BAR
#undef PG8_SCHED
}
}

constexpr int NWAVES = 8;
constexpr int BATCH = 8, SEQ = 4096, D = 1024, T = BATCH * SEQ;
constexpr int NPROJ = 2848, NPROJ_PAD = 3072, DFF = 2816, MEMT = 256;
constexpr int C_NQ = 0, C_KC = 512, C_VC = 640, C_KSL = 768, C_VSL = 896, C_KWN = 1024, C_VWN = 1152, C_GT = 1280, C_MQ = 1304, C_MK = 1560, C_MV = 1816, C_MI = 2328, C_MF = 2332, C_MO = 2336;
constexpr float EPS = 1e-6f;
constexpr int NPHASE = 18;

constexpr size_t MiB = 1u << 20;
constexpr size_t WS_CTL = 0, CTL_ZERO_BYTES = 1 * MiB;
constexpr size_t WS_WIN = 2 * MiB, WS_WOUT = 8 * MiB, WS_WXQ = 10 * MiB, WS_WXKV = 12 * MiB, WS_WXO = 16 * MiB, WS_WGU = 18 * MiB, WS_WDN = 29 * MiB, WS_WC1 = 35 * MiB;
constexpr size_t WS_MEMN = 37 * MiB, WS_MEMK = 41 * MiB, WS_VT = 45 * MiB, WS_CKV = 494 * MiB  , WS_HID = 58 * MiB, WS_KCMP = 62 * MiB;
constexpr size_t WS_H = 64 * MiB, WS_PROJ = 128 * MiB, WS_Y1 = 128 * MiB, WS_ACT = 128 * MiB, WS_YMIX = 320 * MiB, WS_QX = 320 * MiB, WS_Y2 = 320 * MiB, WS_OX = 384 * MiB, WS_CU = 384 * MiB;
constexpr size_t WS_P = 448 * MiB, WS_MQK = 448 * MiB, WS_SMALL = 480 * MiB, WS_END = 512 * MiB;
constexpr size_t SM_BC = 0, SM_GC = 1 * MiB, SM_PM = 2 * MiB, SM_NU = 3 * MiB, SM_MST = 4 * MiB, SM_DEC = 4 * MiB + 65536;
constexpr int CW_TMO = 0, CW_BAR = 4096, CW_CB1 = 16384;

constexpr int RING_BYTES = 131072, LDSCTL_OFF = RING_BYTES, MISC_OFF = LDSCTL_OFF + 320, SCR_OFF = RING_BYTES + 512, LDS_BYTES = 147456;

#define GAS __attribute__((address_space(1)))
#define LAS __attribute__((address_space(3)))
typedef unsigned short bf16;
typedef unsigned v4u __attribute__((ext_vector_type(4)));
typedef float f32x4 __attribute__((ext_vector_type(4)));
typedef GAS unsigned gu32;
#define RLX_AGENT __ATOMIC_RELAXED, __HIP_MEMORY_SCOPE_AGENT
#define LDS_WAIT() asm volatile("s_waitcnt lgkmcnt(0)" ::: "memory")
__device__ __forceinline__ unsigned f2bf(float f) { unsigned u = __builtin_bit_cast(unsigned, f); return (u + 0x7fffu + ((u >> 16) & 1u)) >> 16; }
__device__ __forceinline__ unsigned pk2(float lo, float hi) { return f2bf(lo) | (f2bf(hi) << 16); }
__device__ __forceinline__ float bf2f(unsigned short h) { return __uint_as_float(((unsigned)h) << 16); }
__device__ __forceinline__ float bflo(unsigned w) { return __uint_as_float(w << 16); }
__device__ __forceinline__ float bfhi(unsigned w) { return __uint_as_float(w & 0xffff0000u); }
__device__ __forceinline__ float sigmoid_f(float v) { return 1.0f / (1.0f + __expf(-v)); }

#define XB_TMO      128
#define XB_XCNT(j)  (256  + 64 * (j))
#define XB_XSUB(j)  (1280 + 64 * (j))
#define XB_XGEN(j)  (2304 + 64 * (j))
#define XB_TOP      3328
#define XB_TOPGEN   3392
#define XCD_BAR_WORDS 3456
#define XB_SPIN_CAP (1u << 18)
__device__ __forceinline__ unsigned xb_ld(unsigned* p)              { return __hip_atomic_load(p, __ATOMIC_RELAXED, __HIP_MEMORY_SCOPE_AGENT); }
__device__ __forceinline__ unsigned xb_add(unsigned* p, unsigned v) { return __hip_atomic_fetch_add(p, v, __ATOMIC_RELAXED, __HIP_MEMORY_SCOPE_AGENT); }
__device__ __forceinline__ unsigned xb_xcc_id() { return (unsigned)__builtin_amdgcn_s_getreg((3 << 11) | 20) & 0xFu; }
#define XB_SPIN(cond, bar) do { unsigned _sp = 0; while (cond) { __builtin_amdgcn_s_sleep(1); \
    if ((++_sp & 255u) == 0u) { if (xb_ld(&(bar)[XB_TMO])) break; if (_sp > XB_SPIN_CAP) { atomicAdd(&(bar)[XB_TMO], 1u); break; } } } } while (0)
struct XcdBarrier { unsigned* bar; unsigned x; volatile LAS unsigned* st; };
__device__ __forceinline__ XcdBarrier xcd_barrier_post(unsigned* bar, volatile LAS unsigned* st) {
    XcdBarrier b; b.bar = bar; b.x = xb_xcc_id(); b.st = st;
    if (threadIdx.x == 0) (void)xb_add(&bar[XB_XCNT(b.x)], 1u);
    return b;
}
__device__ __forceinline__ void xcd_barrier_complete(unsigned* bar, unsigned x, unsigned& nloc, unsigned& nx) {
    const unsigned G = gridDim.x * gridDim.y * gridDim.z;
    unsigned sum, cnt, mine, sp = 0u;
    for (;;) {
        sum = 0u; cnt = 0u; mine = 0u;
#pragma unroll
        for (unsigned j = 0; j < 16; ++j) { const unsigned c = xb_ld(&bar[XB_XCNT(j)]); sum += c; cnt += (c > 0u) ? 1u : 0u; mine = (j == x) ? c : mine; }
        if (sum == G) break;
        __builtin_amdgcn_s_sleep(1);
        if ((++sp & 255u) == 0u) { if (xb_ld(&bar[XB_TMO])) break; if (sp > XB_SPIN_CAP) { atomicAdd(&bar[XB_TMO], 1u); break; } }
    }
    nloc = mine > 0u ? mine : 1u; nx = cnt > 0u ? cnt : 1u;
}
__device__ __forceinline__ void xcd_barrier(const XcdBarrier& b) {
    asm volatile("s_waitcnt vmcnt(0)" ::: "memory");
    __syncthreads();
    if (threadIdx.x == 0) {
        unsigned* bar = b.bar;
        __builtin_amdgcn_s_waitcnt(0);
        unsigned nloc = b.st[0], nx = b.st[1];
        if (nloc == 0u) { xcd_barrier_complete(bar, b.x, nloc, nx); b.st[0] = nloc; b.st[1] = nx; }
        const unsigned old = xb_add(&bar[XB_XSUB(b.x)], 1u);
        const unsigned gen = old / nloc;
        if (old + 1u == (gen + 1u) * nloc) {
            __builtin_amdgcn_fence(__ATOMIC_RELEASE, "agent");
            asm volatile("s_waitcnt vmcnt(0)" ::: "memory");
            const unsigned og = xb_add(&bar[XB_TOP], 1u);
            const unsigned tg = og / nx;
            if (og + 1u == (tg + 1u) * nx) xb_add(&bar[XB_TOPGEN], 1u);
            else XB_SPIN(xb_ld(&bar[XB_TOPGEN]) == tg, bar);
            __builtin_amdgcn_fence(__ATOMIC_ACQUIRE, "agent");
            xb_add(&bar[XB_XGEN(b.x)], 1u);
            asm volatile("s_waitcnt vmcnt(0)" ::: "memory");
        } else {
            XB_SPIN(xb_ld(&bar[XB_XGEN(b.x)]) == gen, bar);
            __builtin_amdgcn_fence(__ATOMIC_ACQUIRE, "agent");
            asm volatile("s_waitcnt vmcnt(0)" ::: "memory");
        }
    }
    __syncthreads();
}

__device__ __forceinline__ float wave_sum(float v) {
#pragma unroll
    for (int o = 1; o < 64; o <<= 1) v += __shfl_xor(v, o);
    return v;
}
__device__ __forceinline__ float wave_max(float v) {
#pragma unroll
    for (int o = 1; o < 64; o <<= 1) v = fmaxf(v, __shfl_xor(v, o));
    return v;
}
__device__ const unsigned char kBucket[129] = {
    0, 1, 2, 3, 4, 5, 6, 7, 8, 9, 10, 11, 12, 13, 14, 15, 16, 16, 16, 17, 17, 18, 18, 18, 19, 19, 19, 20, 20, 20, 20, 21, 21, 21, 21, 22, 22, 22, 22, 22,
    23, 23, 23, 23, 23, 23, 24, 24, 24, 24, 24, 24, 25, 25, 25, 25, 25, 25, 25, 26, 26, 26, 26, 26, 26, 26, 26, 27, 27, 27, 27, 27, 27, 27, 27, 27, 27,
    28, 28, 28, 28, 28, 28, 28, 28, 28, 28, 29, 29, 29, 29, 29, 29, 29, 29, 29, 29, 29, 29, 30, 30, 30, 30, 30, 30, 30, 30, 30, 30, 30, 30, 30, 30,
    31, 31, 31, 31, 31, 31, 31, 31, 31, 31, 31, 31, 31, 31, 31, 31};

__device__ __forceinline__ void transpose_item(const float* W, int N, bf16* WT, int ldt, int k0, int n0, int drow0, LAS float* scr, int lane) {
#pragma unroll 8
    for (int i = 0; i < 32; ++i) { const int kk = 2 * i + (lane >> 5); scr[kk * 33 + (lane & 31)] = W[(size_t)(k0 + kk) * N + n0 + (lane & 31)]; }
    LDS_WAIT(); asm volatile("" ::: "memory");
    const int c = lane & 7;
#pragma unroll
    for (int j = 0; j < 4; ++j) { const int n = (lane >> 3) + 8 * j; const LAS float* s = scr + (8 * c) * 33 + n;
        v4u o; o.x = pk2(s[0 * 33], s[1 * 33]); o.y = pk2(s[2 * 33], s[3 * 33]); o.z = pk2(s[4 * 33], s[5 * 33]); o.w = pk2(s[6 * 33], s[7 * 33]);
        *(GAS v4u*)(WT + (size_t)(drow0 + n) * ldt + k0 + 8 * c) = o; }
    LDS_WAIT(); asm volatile("" ::: "memory");
}
__device__ __forceinline__ void rms_row_to_bf16(const float* xrow, const float* gain, bf16* orow, int lane) {
    const GAS f32x4* xr = (const GAS f32x4*)xrow + lane; const GAS f32x4* gr = (const GAS f32x4*)gain + lane;
    f32x4 v[4]; float s = 0.f;
#pragma unroll
    for (int j = 0; j < 4; ++j) { v[j] = xr[64 * j]; s += (v[j].x * v[j].x + v[j].y * v[j].y) + (v[j].z * v[j].z + v[j].w * v[j].w); }
    const float rstd = 1.f / sqrtf(wave_sum(s) * (1.f / D) + EPS);
    GAS unsigned long long* o8 = (GAS unsigned long long*)orow + lane;
#pragma unroll
    for (int j = 0; j < 4; ++j) { const f32x4 g = gr[64 * j];
        o8[64 * j] = (unsigned long long)pk2(v[j].x * rstd * g.x, v[j].y * rstd * g.y) | ((unsigned long long)pk2(v[j].z * rstd * g.z, v[j].w * rstd * g.w) << 32); }
}
__device__ __forceinline__ void resnorm_row(const float* yrow, const float* xi, const float* gpost, float* xo, const float* gpre, bf16* ho, int lane) {
    const GAS f32x4* yr = (const GAS f32x4*)yrow + lane; const GAS f32x4* xr = (const GAS f32x4*)xi + lane; const GAS f32x4* gr = (const GAS f32x4*)gpost + lane;
    f32x4 v[4], x[4]; float s = 0.f;
#pragma unroll
    for (int j = 0; j < 4; ++j) { v[j] = yr[64 * j]; x[j] = xr[64 * j]; s += (v[j].x * v[j].x + v[j].y * v[j].y) + (v[j].z * v[j].z + v[j].w * v[j].w); }
    const float rstd = 1.f / sqrtf(wave_sum(s) * (1.f / D) + EPS);
    float s2 = 0.f;
#pragma unroll
    for (int j = 0; j < 4; ++j) { const f32x4 g = gr[64 * j]; x[j] = x[j] + v[j] * rstd * g; s2 += (x[j].x * x[j].x + x[j].y * x[j].y) + (x[j].z * x[j].z + x[j].w * x[j].w); }
    GAS f32x4* xw = (GAS f32x4*)xo + lane;
#pragma unroll
    for (int j = 0; j < 4; ++j) xw[64 * j] = x[j];
    if (gpre) {
        const float rstd2 = 1.f / sqrtf(wave_sum(s2) * (1.f / D) + EPS);
        const GAS f32x4* g2 = (const GAS f32x4*)gpre + lane; GAS unsigned long long* o8 = (GAS unsigned long long*)ho + lane;
#pragma unroll
        for (int j = 0; j < 4; ++j) { const f32x4 g = g2[64 * j];
            o8[64 * j] = (unsigned long long)pk2(x[j].x * rstd2 * g.x, x[j].y * rstd2 * g.y) | ((unsigned long long)pk2(x[j].z * rstd2 * g.z, x[j].w * rstd2 * g.w) << 32); }
    }
}

struct XaSOrder {
    int G, c;
    __device__ bool next(int i, pg8::Unit& u) const {
        const int L = i * G + c; if (L >= 512) return false;
        const int bz = L >> 4, pm = L & 15, b = bz >> 2, h = bz & 3;
        u.bz = bz; u.orow = b * SEQ + pm * 256; u.ocol = h * 256; return true;
    }
    __device__ __forceinline__ long offA(const pg8::Unit& u) const { return (long)u.orow * D + u.ocol; }
    __device__ __forceinline__ long offB(const pg8::Unit& u) const { return (long)((u.bz >> 2) * MEMT) * D + u.ocol; }
};
struct XaPVOrder {
    int G, c;
    __device__ bool next(int i, pg8::Unit& u) const {
        const int L = i * G + c; if (L >= 512) return false;
        const int bz = L >> 4, pm = L & 15, b = bz >> 2, h = bz & 3;
        u.bz = bz; u.orow = b * SEQ + pm * 256; u.ocol = h * 256; return true;
    }
    __device__ __forceinline__ long offA(const pg8::Unit& u) const { return (long)u.orow * D + u.ocol; }
    __device__ __forceinline__ long offB(const pg8::Unit& u) const { return (long)u.ocol * (BATCH * MEMT) + (u.bz >> 2) * MEMT; }
};
struct CmpOrder {
    int G, c;
    __device__ bool next(int i, pg8::Unit& u) const {
        const int L = i * G + c; if (L >= 32) return false;
        const int kv = L >> 4, pm = L & 15;
        u.bz = kv; u.orow = kv * 4096 + pm * 256; u.ocol = 0; return true;
    }
    __device__ __forceinline__ long offA(const pg8::Unit& u) const { return (long)u.orow * 1024; }
    __device__ __forceinline__ long offB(const pg8::Unit& u) const { return (long)u.bz * 256 * 2048; }
};

namespace nsa {
typedef short bf16x8 __attribute__((ext_vector_type(8)));
typedef short s16x4 __attribute__((ext_vector_type(4)));
typedef float f32x16 __attribute__((ext_vector_type(16)));
typedef unsigned u32x4 __attribute__((ext_vector_type(4)));
typedef unsigned u32x2 __attribute__((ext_vector_type(2)));
typedef short v4i16_t __attribute__((ext_vector_type(4)));
typedef LAS const char* lds_cptr;
constexpr int SLOTB = 8192;
constexpr int L_K = 0, L_V = 3 * SLOTB, L_IMP = 6 * SLOTB, L_SEL = L_IMP + 64 * 65 * 4, L_BIAS = L_SEL + 512, L_END = L_BIAS + 8 * 320 * 4;
constexpr float LOG2E = 1.4426950408889634f;
constexpr float QSCALE = 0.125f * LOG2E;
constexpr float FIX = 67108864.0f;
__device__ __forceinline__ int crow(int r, int hi) { return (r & 3) + 8 * (r >> 2) + 4 * hi; }
__device__ __forceinline__ void glds16(const void* gsrc, unsigned lds_dst) { unsigned keep;
    asm volatile("s_mov_b32 %0, m0\n\ts_mov_b32 m0, %2\n\ts_nop 0\n\tglobal_load_lds_dwordx4 %1, off\n\ts_mov_b32 m0, %0" : "=&s"(keep) : "v"(gsrc), "s"(lds_dst) : "memory"); }
__device__ __forceinline__ unsigned cvtpk(float lo, float hi) { unsigned r; asm("v_cvt_pk_bf16_f32 %0, %1, %2" : "=v"(r) : "v"(lo), "v"(hi)); return r; }
__device__ __forceinline__ s16x4 vtr(lds_cptr p) { return __builtin_bit_cast(s16x4, __builtin_amdgcn_ds_read_tr16_b64_v4i16((LAS v4i16_t*)p)); }
__device__ __forceinline__ float swapmax(float m) { auto rr = __builtin_amdgcn_permlane32_swap(__float_as_uint(m), __float_as_uint(m), false, false); return fmaxf(__uint_as_float(rr[0]), __uint_as_float(rr[1])); }
__device__ __forceinline__ float swapsum(float m) { auto rr = __builtin_amdgcn_permlane32_swap(__float_as_uint(m), __float_as_uint(m), false, false); return __uint_as_float(rr[0]) + __uint_as_float(rr[1]); }
#define NSA_WAIT_BAR(N) asm volatile("s_waitcnt vmcnt(" #N ") lgkmcnt(0)\n\ts_barrier" ::: "memory")

struct Tensors { const bf16* PROJ; const bf16* KCB; const bf16* VCB; bf16* Y; };

__device__ __forceinline__ void qkt(f32x16& p0, f32x16& p1, lds_cptr kb, const bf16x8 (&qr)[4]) {
    p0 = (f32x16){}; p1 = (f32x16){};
#pragma unroll
    for (int d0 = 0; d0 < 4; ++d0) { const bf16x8 b0 = *(const LAS bf16x8*)(kb + d0 * 2048), b1 = *(const LAS bf16x8*)(kb + d0 * 2048 + 512);
        p0 = __builtin_amdgcn_mfma_f32_32x32x16_bf16(b0, qr[d0], p0, 0, 0, 0); p1 = __builtin_amdgcn_mfma_f32_32x32x16_bf16(b1, qr[d0], p1, 0, 0, 0); }
}
__device__ __forceinline__ void pv(f32x16 (&o)[2], lds_cptr vp, const f32x16& p0, const f32x16& p1) {
    u32x4 pw[4];
    pw[0] = (u32x4){cvtpk(p0[0], p0[1]), cvtpk(p0[2], p0[3]), cvtpk(p0[4], p0[5]), cvtpk(p0[6], p0[7])}; pw[1] = (u32x4){cvtpk(p0[8], p0[9]), cvtpk(p0[10], p0[11]), cvtpk(p0[12], p0[13]), cvtpk(p0[14], p0[15])};
    pw[2] = (u32x4){cvtpk(p1[0], p1[1]), cvtpk(p1[2], p1[3]), cvtpk(p1[4], p1[5]), cvtpk(p1[6], p1[7])}; pw[3] = (u32x4){cvtpk(p1[8], p1[9]), cvtpk(p1[10], p1[11]), cvtpk(p1[12], p1[13]), cvtpk(p1[14], p1[15])};
#pragma unroll
    for (int d0 = 0; d0 < 2; ++d0)
#pragma unroll
        for (int ks = 0; ks < 4; ++ks) { const s16x4 lo = vtr(vp + d0 * 4096 + ks * 1024), hh = vtr(vp + d0 * 4096 + ks * 1024 + 512);
            const bf16x8 vf = (bf16x8){lo[0], lo[1], lo[2], lo[3], hh[0], hh[1], hh[2], hh[3]};
            o[d0] = __builtin_amdgcn_mfma_f32_32x32x16_bf16(vf, __builtin_bit_cast(bf16x8, pw[ks]), o[d0], 0, 0, 0); }
}
__device__ __forceinline__ void online(f32x16& p0, f32x16& p1, float& m, float& l, f32x16 (&o)[2]) {
    float rm = fmaxf(p0[0], p1[0]);
#pragma unroll
    for (int r = 1; r < 16; ++r) rm = fmaxf(rm, fmaxf(p0[r], p1[r]));
    rm = swapmax(rm);
    const float mn = fmaxf(m, rm), f = __builtin_amdgcn_exp2f(m - mn); m = mn; l *= f;
#pragma unroll
    for (int r = 0; r < 16; ++r) { o[0][r] *= f; o[1][r] *= f; }
    float s = 0.f;
#pragma unroll
    for (int r = 0; r < 16; ++r) { p0[r] = __builtin_amdgcn_exp2f(p0[r] - mn); p1[r] = __builtin_amdgcn_exp2f(p1[r] - mn); s += p0[r] + p1[r]; }
    l += s;
}
__device__ __forceinline__ void acc_o(f32x16 (&res)[2], const f32x16 (&o)[2], float sc) {
#pragma unroll
    for (int d0 = 0; d0 < 2; ++d0)
#pragma unroll
        for (int r = 0; r < 16; ++r) res[d0][r] += o[d0][r] * sc;
}
__device__ __forceinline__ void unit(const Tensors& A, int b, int hkv, int qt, LAS unsigned char* lds) {
    int tid_ = threadIdx.x; asm volatile("" : "+v"(tid_));
    const int tid = tid_, lane = tid & 63, r32 = lane & 31, hi = lane >> 5; const int wid = __builtin_amdgcn_readfirstlane(tid >> 6), g = wid >> 1, th = wid & 1, h8 = hkv * 4 + g;
    const int tl = 32 * th + r32, tq = 64 * qt + tl; const long rowb = (long)b * SEQ;
    const bf16* prow = A.PROJ + (rowb + tq) * NPROJ_PAD;
    bf16x8 qr[4];
#pragma unroll
    for (int d0 = 0; d0 < 4; ++d0) qr[d0] = *(const bf16x8*)(prow + h8 * 64 + d0 * 16 + hi * 8);
    float gateC, gateS, gateW;
    { const bf16* gp = prow + C_GT + h8 * 3; gateC = 1.0f / (1.0f + __expf(-bf2f(gp[0]))); gateS = 1.0f / (1.0f + __expf(-bf2f(gp[1]))); gateW = 1.0f / (1.0f + __expf(-bf2f(gp[2]))); }
    f32x16 res[2]; res[0] = (f32x16){}; res[1] = (f32x16){};
    const unsigned lds0 = (unsigned)(size_t)lds; const unsigned kdst = lds0 + L_K + wid * 1024, vdst = lds0 + L_V + wid * 1024;
    const lds_cptr kp0 = (lds_cptr)lds + L_K + hi * 1024 + r32 * 16;
    const lds_cptr vp0 = (lds_cptr)lds + L_V + ((lane >> 4) & 1) * 32 + (lane & 3) * 8 + (4 * hi + ((lane & 15) >> 2)) * 64;
    const LAS float* bX = (const LAS float*)(lds + L_BIAS) + h8 * 320;
    LAS unsigned* imp = (LAS unsigned*)(lds + L_IMP);
    LAS unsigned* selm = (LAS unsigned*)(lds + L_SEL);
    const float bfar = bX[64 + 128];
    const float NEG = -INFINITY;
#define NSA_KOFF(P) ((long)lane * (P) + wid * 8)
#define NSA_VOFF(P) ((long)(16 * (wid & 3) + (lane >> 2)) * (P) + (wid >> 2) * 32 + (lane & 3) * 8)
#define NSA_DMA(kb, vb, slot) do { glds16((kb), (unsigned)__builtin_amdgcn_readfirstlane(kdst + (slot))); glds16((vb), (unsigned)__builtin_amdgcn_readfirstlane(vdst + (slot))); } while (0)
    for (int i = tid; i < 64 * 65; i += 512) imp[i] = 0u;

    const int cmax = (4 * qt + 2) < 254 ? (4 * qt + 2) : 254, nct = (cmax >> 6) + 1;
    const bf16* kcb = A.KCB + (size_t)(b * 2 + hkv) * 256 * 64; const bf16* vcb = A.VCB + (size_t)(b * 2 + hkv) * 256 * 64;
    float mC = -1e30f, lC = 0.f; f32x16 oC[2]; oC[0] = (f32x16){}; oC[1] = (f32x16){};
    const int dlc = tq - 31 - 16 * 4 * hi;
#pragma unroll 1
    for (int pass = 0; pass < 2; ++pass) {
        float invl = 0.f;
        if (pass == 1) { const float lt = swapsum(lC); invl = lt > 0.f ? 1.0f / lt : 0.f; }
        { const bf16* k0 = kcb + NSA_KOFF(64); const bf16* v0 = vcb + NSA_VOFF(64); NSA_DMA(k0, v0, 0); const int t1 = nct > 1 ? 1 : 0; NSA_DMA(k0 + (long)t1 * 64 * 64, v0 + (long)t1 * 64 * 64, SLOTB); }
        int sl = 0;
#pragma unroll 1
        for (int ct = 0; ct < nct; ++ct) {
            NSA_WAIT_BAR(2);
            { const int t2 = (ct + 2 < nct) ? ct + 2 : nct - 1; const int s2 = sl >= SLOTB ? sl - SLOTB : sl + 2 * SLOTB;
              NSA_DMA(kcb + NSA_KOFF(64) + (long)t2 * 64 * 64, vcb + NSA_VOFF(64) + (long)t2 * 64 * 64, s2); }
            f32x16 p0, p1; qkt(p0, p1, kp0 + sl, qr);
            const int dt = dlc - 1024 * ct;
#pragma unroll
            for (int r = 0; r < 16; ++r) { const int kvr = (r & 3) + 8 * (r >> 2); const int d0_ = dt - 16 * kvr, d1_ = d0_ - 512;
                const int c0_ = 64 * ct + kvr + 4 * hi;
                const int i0 = d0_ < 0 ? 0 : (d0_ > 128 ? 128 : d0_), i1 = d1_ < 0 ? 0 : (d1_ > 128 ? 128 : d1_);
                p0[r] = (d0_ >= 0 && c0_ <= 254) ? p0[r] + bX[64 + i0] : NEG; p1[r] = (d1_ >= 0 && c0_ + 32 <= 254) ? p1[r] + bX[64 + i1] : NEG; }
            if (pass == 0) {
                float rm = fmaxf(p0[0], p1[0]);
#pragma unroll
                for (int r = 1; r < 16; ++r) rm = fmaxf(rm, fmaxf(p0[r], p1[r]));
                rm = swapmax(rm);
                const float mn = fmaxf(mC, rm), f = __builtin_amdgcn_exp2f(mC - mn); mC = mn; lC *= f; float s = 0.f;
#pragma unroll
                for (int r = 0; r < 16; ++r) s += __builtin_amdgcn_exp2f(p0[r] - mn) + __builtin_amdgcn_exp2f(p1[r] - mn);
                lC += s;
            } else {
#pragma unroll
                for (int r = 0; r < 16; ++r) { p0[r] = __builtin_amdgcn_exp2f(p0[r] - mC) * invl; p1[r] = __builtin_amdgcn_exp2f(p1[r] - mC) * invl; }
#pragma unroll
                for (int a = 0; a < 4; ++a) { const int j0 = 16 * ct + 2 * a + hi;
                    const float g0 = (p0[4 * a] + p0[4 * a + 1]) + (p0[4 * a + 2] + p0[4 * a + 3]), g1 = (p1[4 * a] + p1[4 * a + 1]) + (p1[4 * a + 2] + p1[4 * a + 3]);
                    __hip_atomic_fetch_add(imp + tl * 65 + j0, (unsigned)(g0 * FIX), __ATOMIC_RELAXED, __HIP_MEMORY_SCOPE_WORKGROUP);
                    __hip_atomic_fetch_add(imp + tl * 65 + j0 + 1, (unsigned)(p0[4 * a + 3] * FIX), __ATOMIC_RELAXED, __HIP_MEMORY_SCOPE_WORKGROUP);
                    __hip_atomic_fetch_add(imp + tl * 65 + j0 + 8, (unsigned)(g1 * FIX), __ATOMIC_RELAXED, __HIP_MEMORY_SCOPE_WORKGROUP);
                    __hip_atomic_fetch_add(imp + tl * 65 + j0 + 9, (unsigned)(p1[4 * a + 3] * FIX), __ATOMIC_RELAXED, __HIP_MEMORY_SCOPE_WORKGROUP); }
                pv(oC, vp0 + sl, p0, p1);
            }
            sl = sl >= 2 * SLOTB ? 0 : sl + SLOTB;
        }
        NSA_WAIT_BAR(0);
    }
#pragma unroll 1
    for (int i = 0; i < 8; ++i) { const int t2 = 8 * wid + i; const unsigned sc = imp[t2 * 65 + lane];
        const bool forced = (lane == 0) || (lane == qt) || (lane == qt - 1);
        const unsigned score = forced ? 0xffffffffu : (lane <= qt ? sc + 1u : 0u);
        int rank = 0;
#pragma unroll 4
        for (int jj = 0; jj < 64; ++jj) { const unsigned sj = (unsigned)__builtin_amdgcn_readlane((int)score, jj); rank += ((sj > score) || (sj == score && jj < lane)) ? 1 : 0; }
        unsigned long long sel = __ballot(rank < 16); sel &= (qt == 63) ? ~0ull : ((1ull << (qt + 1)) - 1ull);
        if (lane == 0) { selm[2 * t2] = (unsigned)sel; selm[2 * t2 + 1] = (unsigned)(sel >> 32); } }
    NSA_WAIT_BAR(0);
    const unsigned long long mysel = (unsigned long long)selm[2 * tl] | ((unsigned long long)selm[2 * tl + 1] << 32);
    acc_o(res, oC, gateC);

    {
        const bf16* kb0 = A.PROJ + rowb * NPROJ_PAD + C_KSL + 64 * hkv + NSA_KOFF(NPROJ_PAD); const bf16* vb0 = A.PROJ + rowb * NPROJ_PAD + C_VSL + 64 * hkv + NSA_VOFF(NPROJ_PAD);
        float m = -1e30f, l = 0.f; f32x16 o[2]; o[0] = (f32x16){}; o[1] = (f32x16){};
        { NSA_DMA(kb0, vb0, 0); const int t1 = qt > 0 ? 1 : 0; NSA_DMA(kb0 + (long)t1 * 64 * NPROJ_PAD, vb0 + (long)t1 * 64 * NPROJ_PAD, SLOTB); }
        int sl = 0;
#pragma unroll 1
        for (int j = 0; j <= qt; ++j) {
            NSA_WAIT_BAR(2);
            { const int t2 = (j + 2 <= qt) ? j + 2 : qt; const int s2 = sl >= SLOTB ? sl - SLOTB : sl + 2 * SLOTB; NSA_DMA(kb0 + (long)t2 * 64 * NPROJ_PAD, vb0 + (long)t2 * 64 * NPROJ_PAD, s2); }
            f32x16 p0, p1; qkt(p0, p1, kp0 + sl, qr);
            const bool on = (mysel >> j) & 1ull;
            if (j + 3 <= qt) {
#pragma unroll
                for (int r = 0; r < 16; ++r) { p0[r] = on ? p0[r] + bfar : NEG; p1[r] = on ? p1[r] + bfar : NEG; }
            } else {
                const int dl = tq - 64 * j - 4 * hi;
#pragma unroll
                for (int r = 0; r < 16; ++r) { const int kvr = (r & 3) + 8 * (r >> 2); const int d0_ = dl - kvr, d1_ = d0_ - 32;
                    p0[r] = (on && d0_ >= 0) ? p0[r] + bX[64 + d0_] : NEG; p1[r] = (on && d1_ >= 0) ? p1[r] + bX[64 + d1_] : NEG; }
            }
            online(p0, p1, m, l, o);
            pv(o, vp0 + sl, p0, p1);
            sl = sl >= 2 * SLOTB ? 0 : sl + SLOTB;
        }
        NSA_WAIT_BAR(0);
        const float lt = swapsum(l); acc_o(res, o, lt > 0.f ? gateS / lt : 0.f);
    }
    {
        const bf16* kb0 = A.PROJ + rowb * NPROJ_PAD + C_KWN + 64 * hkv + NSA_KOFF(NPROJ_PAD); const bf16* vb0 = A.PROJ + rowb * NPROJ_PAD + C_VWN + 64 * hkv + NSA_VOFF(NPROJ_PAD);
        float m = -1e30f, l = 0.f; f32x16 o[2]; o[0] = (f32x16){}; o[1] = (f32x16){};
        const int jlo = qt > 8 ? qt - 8 : 0;
        { NSA_DMA(kb0 + (long)jlo * 64 * NPROJ_PAD, vb0 + (long)jlo * 64 * NPROJ_PAD, 0); const int t1 = jlo + 1 <= qt ? jlo + 1 : qt; NSA_DMA(kb0 + (long)t1 * 64 * NPROJ_PAD, vb0 + (long)t1 * 64 * NPROJ_PAD, SLOTB); }
        int sl = 0;
#pragma unroll 1
        for (int j = jlo; j <= qt; ++j) {
            NSA_WAIT_BAR(2);
            { const int t2 = (j + 2 <= qt) ? j + 2 : qt; const int s2 = sl >= SLOTB ? sl - SLOTB : sl + 2 * SLOTB; NSA_DMA(kb0 + (long)t2 * 64 * NPROJ_PAD, vb0 + (long)t2 * 64 * NPROJ_PAD, s2); }
            f32x16 p0, p1; qkt(p0, p1, kp0 + sl, qr);
            if (j + 3 <= qt) {
                const bool edge = (j + 8 == qt);
#pragma unroll
                for (int r = 0; r < 16; ++r) { const int kv0 = (r & 3) + 8 * (r >> 2) + 4 * hi;
                    p0[r] = (!edge || kv0 > tl) ? p0[r] + bfar : NEG; p1[r] = (!edge || kv0 + 32 > tl) ? p1[r] + bfar : NEG; }
            } else {
                const int dl = tq - 64 * j - 4 * hi;
#pragma unroll
                for (int r = 0; r < 16; ++r) { const int kvr = (r & 3) + 8 * (r >> 2); const int d0_ = dl - kvr, d1_ = d0_ - 32;
                    p0[r] = (d0_ >= 0) ? p0[r] + bX[64 + d0_] : NEG; p1[r] = (d1_ >= 0) ? p1[r] + bX[64 + d1_] : NEG; }
            }
            online(p0, p1, m, l, o);
            pv(o, vp0 + sl, p0, p1);
            sl = sl >= 2 * SLOTB ? 0 : sl + SLOTB;
        }
        NSA_WAIT_BAR(0);
        const float lt = swapsum(l); acc_o(res, o, lt > 0.f ? gateW / lt : 0.f);
    }
    {
        bf16* dst = A.Y + (size_t)(rowb + tq) * D + h8 * 64;
#pragma unroll
        for (int d0 = 0; d0 < 2; ++d0)
#pragma unroll
            for (int a = 0; a < 4; ++a) { u32x2 w; w.x = cvtpk(res[d0][4 * a], res[d0][4 * a + 1]); w.y = cvtpk(res[d0][4 * a + 2], res[d0][4 * a + 3]); *(u32x2*)(dst + 32 * d0 + 8 * a + 4 * hi) = w; }
    }
    asm volatile("s_waitcnt vmcnt(0)" ::: "memory");
#undef NSA_KOFF
#undef NSA_VOFF
#undef NSA_DMA
}
}

struct Args { const float* in[27]; float* out; unsigned char* ws; int ph_lo, ph_hi; };
__global__ void __launch_bounds__(NWAVES * 64, 2) hymba_fwd(Args args) {
    extern __shared__ __attribute__((aligned(16))) unsigned char lds_raw[];
    LAS unsigned char* lds = (LAS unsigned char*)lds_raw;
    volatile LAS unsigned* MISC = (volatile LAS unsigned*)(lds + MISC_OFF);
    const int tid = threadIdx.x, lane = tid & 63, wave = __builtin_amdgcn_readfirstlane(tid >> 6);
    const int G = gridDim.x; const int bx = blockIdx.x; const int vcu = (G % 8 == 0) ? (bx % 8) * (G / 8) + bx / 8 : bx;
    const int gw = vcu * NWAVES + wave, NGW = G * NWAVES;
    const long gtid = (long)vcu * 512 + tid, NGT = (long)G * 512;
    unsigned char* ws = args.ws;
    gu32* ctl = (gu32*)(ws + WS_CTL);
#define x_in ((const float*)args.in[0])
#define mem_in ((const float*)args.in[1])
#define rel_bias ((const float*)args.in[2])
#define g_mix_pre ((const float*)args.in[3])
#define w_in ((const float*)args.in[4])
#define cmp_pos_k ((const float*)args.in[5])
#define cmp_pos_v ((const float*)args.in[6])
#define cmp_w1_k ((const float*)args.in[7])
#define cmp_w2_k ((const float*)args.in[8])
#define cmp_w1_v ((const float*)args.in[9])
#define cmp_w2_v ((const float*)args.in[10])
#define conv_w ((const float*)args.in[11])
#define conv_b ((const float*)args.in[12])
#define gate_bias ((const float*)args.in[13])
#define mlstm_norm ((const float*)args.in[14])
#define w_out ((const float*)args.in[15])
#define g_mix_post ((const float*)args.in[16])
#define g_x_pre ((const float*)args.in[17])
#define g_mem ((const float*)args.in[18])
#define w_xq ((const float*)args.in[19])
#define w_xkv ((const float*)args.in[20])
#define w_xo ((const float*)args.in[21])
#define g_x_post ((const float*)args.in[22])
#define g_ffn_pre ((const float*)args.in[23])
#define w_gate_up ((const float*)args.in[24])
#define w_down ((const float*)args.in[25])
#define g_ffn_post ((const float*)args.in[26])
#define out_p (args.out)
#define Win_t ((bf16*)(ws + WS_WIN))
#define Wout_t ((bf16*)(ws + WS_WOUT))
#define Wxq_t ((bf16*)(ws + WS_WXQ))
#define Wxkv_t ((bf16*)(ws + WS_WXKV))
#define Wxo_t ((bf16*)(ws + WS_WXO))
#define Wgu_t ((bf16*)(ws + WS_WGU))
#define Wdn_t ((bf16*)(ws + WS_WDN))
#define Wc1_t ((bf16*)(ws + WS_WC1))
#define MEMN ((bf16*)(ws + WS_MEMN))
#define MEMK ((bf16*)(ws + WS_MEMK))
#define VT ((bf16*)(ws + WS_VT))
#define CKV ((bf16*)(ws + WS_CKV))
#define HID ((bf16*)(ws + WS_HID))
#define KCMP ((float*)(ws + WS_KCMP))
#define H ((bf16*)(ws + WS_H))
#define PROJ ((bf16*)(ws + WS_PROJ))
#define Y1 ((float*)(ws + WS_Y1))
#define ACT ((bf16*)(ws + WS_ACT))
#define YMIX ((bf16*)(ws + WS_YMIX))
#define QX ((bf16*)(ws + WS_QX))
#define Y2 ((float*)(ws + WS_Y2))
#define OX ((bf16*)(ws + WS_OX))
#define CU ((float*)(ws + WS_CU))
#define PB ((bf16*)(ws + WS_P))
#define MQK ((bf16*)(ws + WS_MQK))
#define Bc ((float*)(ws + WS_SMALL + SM_BC))
#define Gc ((float*)(ws + WS_SMALL + SM_GC))
#define PM ((float*)(ws + WS_SMALL + SM_PM))
#define NU ((float*)(ws + WS_SMALL + SM_NU))
#define MST ((float*)(ws + WS_SMALL + SM_MST))
#define DEC ((float*)(ws + WS_SMALL + SM_DEC))
#define CB1 ((float*)(ws + WS_SMALL + 9 * MiB))
#define CB1P ((float*)(ws + WS_SMALL + 9 * MiB + 4096))
#define UT ((float*)(ws + WS_CU))
#define CS ((bf16*)(ws + WS_H))
#define NUT ((float*)(ws + WS_SMALL + SM_NU))
#define NS ((float*)(ws + WS_SMALL + SM_NU + 524288))
#define BLA ((float*)(ws + WS_SMALL + SM_MST + 16384))
#define GMA ((float*)(ws + WS_SMALL + SM_MST + 32768))
#define KCB ((bf16*)(ws + WS_SMALL + 6 * MiB))
#define VCB (KCB + (size_t)BATCH * 2 * 256 * 64)
    for (int u = tid; u < (LDS_BYTES - LDSCTL_OFF) / 4; u += NWAVES * 64) ((LAS unsigned*)(lds + LDSCTL_OFF))[u] = 0u;
    __syncthreads();
    XcdBarrier bar; bar.bar = (unsigned*)ctl + CW_BAR; bar.x = 0; bar.st = nullptr;
    if (MK_ONE_LAUNCH) bar = xcd_barrier_post((unsigned*)ctl + CW_BAR, MISC + 8);
    const int lo = args.ph_lo, hi = args.ph_hi;
#if defined(DBG_MASK)
#define IN(k) (((DBG_MASK >> (k)) & 1) && lo <= (k) && (k) < hi)
#elif defined(DBG_ONLY)
#define IN(k) ((k) == DBG_ONLY && lo <= (k) && (k) < hi)
#else
#define IN(k) (lo <= (k) && (k) < hi)
#endif
#define SEAM(k) do { if (MK_ONE_LAUNCH && IN(k) && IN((k) + 1)) xcd_barrier(bar); } while (0)

    if (IN(0)) {
        LAS float* scr = (LAS float*)(lds + wave * 16384);
        constexpr int I_IN = 16 * 89, I_SQ = 16 * 32, I_KV = 16 * 64, I_GU = 16 * 176, I_DN = 44 * 32, I_C1 = 32 * 8;
        constexpr int NITEMS = I_IN + 3 * I_SQ + I_KV + I_GU + I_DN + 2 * I_C1;
        for (int it = gw; it < NITEMS; it += NGW) {
            int r = it;
            if (r < I_IN) { const int kb = r / 89, nb = r % 89; transpose_item(w_in, NPROJ, Win_t, D, 64 * kb, 32 * nb, 32 * nb, scr, lane); continue; } r -= I_IN;
            if (r < I_SQ) { const int kb = r / 32, nb = r % 32; transpose_item(w_out, D, Wout_t, D, 64 * kb, 32 * nb, 32 * nb, scr, lane); continue; } r -= I_SQ;
            if (r < I_SQ) { const int kb = r / 32, nb = r % 32; transpose_item(w_xq, D, Wxq_t, D, 64 * kb, 32 * nb, 32 * nb, scr, lane); continue; } r -= I_SQ;
            if (r < I_SQ) { const int kb = r / 32, nb = r % 32; transpose_item(w_xo, D, Wxo_t, D, 64 * kb, 32 * nb, 32 * nb, scr, lane); continue; } r -= I_SQ;
            if (r < I_KV) { const int kb = r / 64, nb = r % 64; transpose_item(w_xkv, 2 * D, Wxkv_t, D, 64 * kb, 32 * nb, 32 * nb, scr, lane); continue; } r -= I_KV;
            if (r < I_GU) { const int kb = r / 176, nb = r % 176; const int n0 = 32 * nb; const int isu = n0 >= DFF ? 1 : 0, nn = n0 - isu * DFF;
                            transpose_item(w_gate_up, 2 * DFF, Wgu_t, D, 64 * kb, n0, 256 * (nn >> 7) + 128 * isu + (nn & 127), scr, lane); continue; } r -= I_GU;
            if (r < I_DN) { const int kb = r / 32, nb = r % 32; transpose_item(w_down, D, Wdn_t, DFF, 64 * kb, 32 * nb, 32 * nb, scr, lane); continue; } r -= I_DN;
            if (r < I_C1) { const int kb = r / 8, nb = r % 8; transpose_item(cmp_w1_k, 256, Wc1_t, 2048, 64 * kb, 32 * nb, 32 * nb, scr, lane); continue; } r -= I_C1;
            { const int kb = r / 8, nb = r % 8; transpose_item(cmp_w1_v, 256, Wc1_t + 256 * 2048, 2048, 64 * kb, 32 * nb, 32 * nb, scr, lane); }
        }
        for (long i = gtid; i < (long)(NPROJ_PAD - NPROJ) * D / 8; i += NGT) ((GAS v4u*)(Win_t + (size_t)NPROJ * D))[i] = (v4u){0u, 0u, 0u, 0u};
        for (int it = gw; it < 256; it += NGW) {
            const int kv = it >> 7, nc = (it >> 5) & 3, kc = it & 31; const float* pos = kv ? cmp_pos_v : cmp_pos_k; const float* w1 = kv ? cmp_w1_v : cmp_w1_k;
            float a = 0.f;
#pragma unroll 8
            for (int kk = 0; kk < 64; ++kk) a += pos[kc * 64 + kk] * w1[(size_t)(kc * 64 + kk) * 256 + nc * 64 + lane];
            CB1P[(kv * 32 + kc) * 256 + nc * 64 + lane] = a;
        }
        for (int m = gw; m < T; m += NGW) rms_row_to_bf16(x_in + (size_t)m * D, g_mix_pre, H + (size_t)m * D, lane);
        for (int m = gw; m < BATCH * MEMT; m += NGW) rms_row_to_bf16(mem_in + (size_t)m * D, g_mem, MEMN + (size_t)m * D, lane);
    }
    SEAM(0);

    if (IN(1)) {
        for (long i = gtid; i < 512; i += NGT) { const int kv = (int)i >> 8, n = (int)i & 255; float a = 0.f; for (int kc = 0; kc < 32; ++kc) a += CB1P[(kv * 32 + kc) * 256 + n]; CB1[i] = a; }
        { pg8::Gemm g{H, Win_t, D, D, D}; pg8::GridOrder S; S.init(T, NPROJ_PAD, D, D, G, bx); pg8::EpiBf16 E{PROJ, NPROJ_PAD, 1.0f, nsa::QSCALE, 512};
          pg8::gemm_phase<pg8::EpiBf16, pg8::GridOrder, true, true>(lds, g, S, E); }
        { pg8::Gemm g{MEMN, Wxkv_t, D, D, D}; pg8::GridOrder S; S.init(BATCH * MEMT, D, D, D, G, bx); pg8::EpiBf16 E{MEMK, D, 1.0f, 1.0f, 0};
          pg8::gemm_phase<pg8::EpiBf16, pg8::GridOrder, true, true>(lds, g, S, E); }
        { pg8::Gemm g{Wxkv_t + (size_t)D * D, MEMN, D, D, D}; pg8::GridOrder S; S.init(D, BATCH * MEMT, D, D, G, bx); pg8::EpiBf16 E{VT, BATCH * MEMT, 1.0f, 1.0f, 0};
          pg8::gemm_phase<pg8::EpiBf16, pg8::GridOrder, true, true>(lds, g, S, E); }
    }
    SEAM(1);

    if (IN(2)) {
        const unsigned lds0 = (unsigned)(size_t)lds; LAS float* wL = (LAS float*)(lds + 98304);
        const int hi = lane >> 5; const int loff = ((lane >> 4) & 1) * 32 + (lane & 3) * 8 + (4 * hi + ((lane & 15) >> 2)) * 64;
        for (int it = vcu; it < 512; it += G) {
            const int b = it >> 6, k = it & 63; const size_t t0 = (size_t)b * SEQ + 64 * k;
#pragma unroll
            for (int i = 0; i < 8; ++i) { const int pc = 8 * i + wave, hh = pc >> 4, vq = (pc >> 2) & 3, rq = pc & 3;
                nsa::glds16(PROJ + (t0 + 16 * rq + (lane >> 2)) * NPROJ_PAD + C_MV + 128 * hh + 32 * vq + (lane & 3) * 8, (unsigned)__builtin_amdgcn_readfirstlane(lds0 + hh * 16384 + vq * 4096 + rq * 1024)); }
            if (wave < 4) { const int h = wave; const size_t t = t0 + lane;
                const float ip = bf2f(PROJ[t * NPROJ_PAD + C_MI + h]) + gate_bias[h], fp = bf2f(PROJ[t * NPROJ_PAD + C_MF + h]) + gate_bias[4 + h];
                const float lf = fminf(fp, 0.f) - log1pf(__expf(-fabsf(fp)));
                float bs = lf;
#pragma unroll
                for (int o = 1; o < 64; o <<= 1) { const float v = __shfl_up(bs, o); if (lane >= o) bs += v; }
                const float gg = ip - bs; float pmx = gg;
#pragma unroll
                for (int o = 1; o < 64; o <<= 1) { const float v = __shfl_up(pmx, o); if (lane >= o) pmx = fmaxf(pmx, v); }
                Bc[t * 4 + h] = bs; Gc[t * 4 + h] = gg; PM[t * 4 + h] = pmx;
                const float bL = __shfl(bs, 63), gmax = __shfl(pmx, 63);
                wL[h * 64 + lane] = 0.125f * __expf(gg - gmax);
                if (lane == 0) { BLA[(b * 4 + h) * 64 + k] = bL; GMA[(b * 4 + h) * 64 + k] = gmax; } }
            __syncthreads();
#pragma unroll 2
            for (int i = 0; i < 8; ++i) { const int idx = tid + 512 * i, s = idx >> 6, c0 = (idx & 63) * 8; const size_t t = t0 + s; const int tt = 64 * k + s;
                float a[8];
#pragma unroll
                for (int e = 0; e < 8; ++e) a[e] = conv_b[c0 + e];
#pragma unroll
                for (int j = 0; j < 4; ++j) { if (tt - 3 + j >= 0) { const v4u u = *(const GAS v4u*)(PROJ + (size_t)(t - 3 + j) * NPROJ_PAD + C_MQ + c0); const float* cw = conv_w + j * 512 + c0;
                    a[0] += cw[0] * bflo(u.x); a[1] += cw[1] * bfhi(u.x); a[2] += cw[2] * bflo(u.y); a[3] += cw[3] * bfhi(u.y);
                    a[4] += cw[4] * bflo(u.z); a[5] += cw[5] * bfhi(u.z); a[6] += cw[6] * bflo(u.w); a[7] += cw[7] * bfhi(u.w); } }
#pragma unroll
                for (int e = 0; e < 8; ++e) a[e] = a[e] * sigmoid_f(a[e]);
                v4u o; o.x = pk2(a[0], a[1]); o.y = pk2(a[2], a[3]); o.z = pk2(a[4], a[5]); o.w = pk2(a[6], a[7]);
                *(GAS v4u*)(MQK + (size_t)t * 512 + c0) = o;
                if (c0 >= 256) { const int d = c0 - 256, hh = d >> 6, dd = d & 63; const float w = wL[hh * 64 + s];
                    v4u o2; o2.x = pk2(a[0] * w, a[1] * w); o2.y = pk2(a[2] * w, a[3] * w); o2.z = pk2(a[4] * w, a[5] * w); o2.w = pk2(a[6] * w, a[7] * w);
                    *(LAS v4u*)(lds + 65536 + hh * 8192 + (dd >> 5) * 4096 + s * 64 + (dd & 31) * 2) = o2; } }
            asm volatile("s_waitcnt vmcnt(0)" ::: "memory"); __syncthreads();
            { const int h = wave >> 1, dg = wave & 1; nsa::f32x16 acc[4]; acc[0] = (nsa::f32x16){}; acc[1] = (nsa::f32x16){}; acc[2] = (nsa::f32x16){}; acc[3] = (nsa::f32x16){};
              const nsa::lds_cptr ab = (nsa::lds_cptr)lds + 65536 + h * 8192 + dg * 4096 + loff, bb = (nsa::lds_cptr)lds + h * 16384 + loff;
#pragma unroll
              for (int ks = 0; ks < 4; ++ks) { const nsa::s16x4 alo = nsa::vtr(ab + ks * 1024), ahi = nsa::vtr(ab + ks * 1024 + 512);
                  const nsa::bf16x8 af = (nsa::bf16x8){alo[0], alo[1], alo[2], alo[3], ahi[0], ahi[1], ahi[2], ahi[3]};
#pragma unroll
                  for (int vt = 0; vt < 4; ++vt) { const nsa::s16x4 blo = nsa::vtr(bb + vt * 4096 + ks * 1024), bhi = nsa::vtr(bb + vt * 4096 + ks * 1024 + 512);
                      const nsa::bf16x8 bfr = (nsa::bf16x8){blo[0], blo[1], blo[2], blo[3], bhi[0], bhi[1], bhi[2], bhi[3]};
                      acc[vt] = __builtin_amdgcn_mfma_f32_32x32x16_bf16(af, bfr, acc[vt], 0, 0, 0); } }
              float* up = UT + ((size_t)((b * 4 + h) * 64 + k) * 64 + 32 * dg) * 128 + (lane & 31);
#pragma unroll
              for (int vt = 0; vt < 4; ++vt)
#pragma unroll
                  for (int r = 0; r < 16; ++r) up[nsa::crow(r, hi) * 128 + 32 * vt] = acc[vt][r]; }
            if (tid < 256) { const int hh = tid >> 6, d = tid & 63; const LAS bf16* kp = (const LAS bf16*)(lds + 65536 + hh * 8192 + (d >> 5) * 4096 + (d & 31) * 2); float un = 0.f;
#pragma unroll 8
                for (int s = 0; s < 64; ++s) un += bf2f(kp[s * 32]);
                NUT[((size_t)(b * 4 + hh) * 64 + k) * 64 + d] = un; }
            __syncthreads();
        }
        for (long i = gtid; i < (long)2 * BATCH * 2 * SEQ * 8; i += NGT) {
            const int ch = (int)(i & 7); const long r = i >> 3; const int t = (int)(r & (SEQ - 1)); const int hkv = (int)((r >> 12) & 1), b = (int)((r >> 13) & 7), kv = (int)(r >> 16);
            *(GAS v4u*)(CKV + (size_t)r * 64 + ch * 8) = *(const GAS v4u*)(PROJ + ((size_t)b * SEQ + t) * NPROJ_PAD + C_KC + kv * 128 + hkv * 64 + ch * 8);
        }
    }
    SEAM(2);

    if (IN(3)) {
        { pg8::Gemm g{CKV, Wc1_t, 1024, 2048, 2048}; CmpOrder S{G, bx}; pg8::EpiSiluBias E{HID, 256, CB1};
          pg8::gemm_phase<pg8::EpiSiluBias, CmpOrder, true, true>(lds, g, S, E); }
        for (long i = gtid; i < (long)32 * 4096 + 32 * 64; i += NGT) {
            if (i < (long)32 * 4096) { const int bh = (int)(i >> 12), e2 = (int)(i & 4095) * 2, d = e2 >> 7, v = e2 & 127; const int gq = (d >> 2) & 3, rho = (d & ~15) + ((gq == 1) ? 8 : (gq == 2) ? 4 : 4 * gq) + (d & 3);
                float c0 = 0.f, c1 = 0.f, m = 0.f;
                for (int k = 0; k < 64; ++k) { const float bL = BLA[bh * 64 + k], lam = bL + GMA[bh * 64 + k]; const float mn = fmaxf(bL + m, lam), dec = __expf(bL + m - mn), sc = __expf(lam - mn);
                    const float2 u = *(const float2*)(UT + (size_t)(bh * 64 + k) * 8192 + e2);
                    *(unsigned*)(CS + ((size_t)(bh * 64 + k) * 64 + rho) * 128 + v) = pk2(c0, c1);
                    if (e2 == 0) MST[bh * 65 + k] = m;
                    c0 = dec * c0 + sc * u.x; c1 = dec * c1 + sc * u.y; m = mn; } }
            else { const long j = i - (long)32 * 4096; const int bh = (int)(j >> 6), e = (int)(j & 63); float c = 0.f, m = 0.f;
                for (int k = 0; k < 64; ++k) { const float bL = BLA[bh * 64 + k], lam = bL + GMA[bh * 64 + k]; const float mn = fmaxf(bL + m, lam), dec = __expf(bL + m - mn), sc = __expf(lam - mn);
                    const float u = NUT[(size_t)(bh * 64 + k) * 64 + e]; NS[(size_t)(bh * 64 + k) * 64 + e] = c; c = dec * c + sc * u; m = mn; } }
        }
    }
    SEAM(3);

    if (IN(4)) {
        for (long i = gtid; i < (long)2 * 4096 * 64; i += NGT) {
            const int c = (int)(i & 63); const long r = i >> 6; const int kv = (int)(r >> 12); const float* w2 = kv ? cmp_w2_v : cmp_w2_k; const bf16* hp = HID + (size_t)r * 256;
            float a = 0.f;
#pragma unroll 8
            for (int n = 0; n < 256; ++n) a += bf2f(hp[n]) * w2[n * 64 + c];
            KCMP[i] = a; KCB[i] = (bf16)((((int)r & 255) == 255) ? 0u : f2bf(a));
        }
    }
    SEAM(4);

    if (IN(5)) {
        LAS float* bXt = (LAS float*)(lds + nsa::L_BIAS);
        for (int idx = tid; idx < 8 * 320; idx += 512) { const int hh = idx / 320; int d = idx % 320 - 64; d = d < 0 ? 0 : (d > 128 ? 128 : d); bXt[idx] = rel_bias[hh * 32 + kBucket[d]] * nsa::LOG2E; }
        __syncthreads();
        const nsa::Tensors NT{PROJ, KCB, VCB, YMIX};
#ifdef PROBE_NSA2
        for (int rep = 0; rep < 2; ++rep)
#endif
        for (int u = vcu; u < 1024; u += G) { const int v = u & 255, i = u >> 8, bh = v >> 4, s = v & 15; const int qt = (i == 0) ? s : (i == 1) ? 31 - s : (i == 2) ? 32 + s : 63 - s;
            nsa::unit(NT, bh >> 1, bh & 1, qt, lds); }
        __syncthreads();
    }
    SEAM(5);

    if (IN(6)) {
        const unsigned lds0 = (unsigned)(size_t)lds; LAS float* gL = (LAS float*)(lds + SCR_OFF); LAS float* nL = gL + 256; LAS float* gnL = nL + 256;
        gnL[tid] = mlstm_norm[tid];
        const int hi = lane >> 5, r32 = lane & 31; const int loff = ((lane >> 4) & 1) * 32 + (lane & 3) * 8 + (4 * hi + ((lane & 15) >> 2)) * 64;
        const int h = wave >> 1, th = wave & 1, tl = 32 * th + r32;
        for (int it = vcu; it < 512; it += G) {
            const int b = it >> 6, k = it & 63; const size_t t0 = (size_t)b * SEQ + 64 * k; const int bh = b * 4 + h;
#pragma unroll
            for (int i = 0; i < 8; ++i) { const int pc = 8 * i + wave, hh = pc >> 4, vq = (pc >> 2) & 3, rq = pc & 3;
                nsa::glds16(PROJ + (t0 + 16 * rq + (lane >> 2)) * NPROJ_PAD + C_MV + 128 * hh + 32 * vq + (lane & 3) * 8, (unsigned)__builtin_amdgcn_readfirstlane(lds0 + hh * 16384 + vq * 4096 + rq * 1024));
                nsa::glds16(CS + ((size_t)((b * 4 + hh) * 64 + k) * 64 + 16 * rq + (lane >> 2)) * 128 + 32 * vq + (lane & 3) * 8, (unsigned)__builtin_amdgcn_readfirstlane(lds0 + 65536 + hh * 16384 + vq * 4096 + rq * 1024)); }
            if (tid < 256) { const int hh = tid >> 6, s = tid & 63; gL[tid] = Gc[(t0 + s) * 4 + hh] * nsa::LOG2E; nL[tid] = NS[((size_t)(b * 4 + hh) * 64 + k) * 64 + s]; }
            const size_t trow = t0 + tl;
            const float bt = Bc[trow * 4 + h], pm = PM[trow * 4 + h], mk = MST[bh * 65 + k]; const float mt = fmaxf(bt + mk, bt + pm), av = __expf(bt + mk - mt), et = (bt - mt) * nsa::LOG2E - 3.0f;
            nsa::bf16x8 qf[4], kf0[4], kf1[4];
#pragma unroll
            for (int d0 = 0; d0 < 4; ++d0) { qf[d0] = *(const nsa::bf16x8*)(MQK + trow * 512 + 64 * h + 16 * d0 + 8 * hi);
                kf0[d0] = *(const nsa::bf16x8*)(MQK + (t0 + r32) * 512 + 256 + 64 * h + 16 * d0 + 8 * hi); kf1[d0] = *(const nsa::bf16x8*)(MQK + (t0 + 32 + r32) * 512 + 256 + 64 * h + 16 * d0 + 8 * hi); }
            nsa::f32x16 p0 = (nsa::f32x16){}, p1 = (nsa::f32x16){};
#pragma unroll
            for (int d0 = 0; d0 < 4; ++d0) { p0 = __builtin_amdgcn_mfma_f32_32x32x16_bf16(kf0[d0], qf[d0], p0, 0, 0, 0); p1 = __builtin_amdgcn_mfma_f32_32x32x16_bf16(kf1[d0], qf[d0], p1, 0, 0, 0); }
            asm volatile("s_waitcnt vmcnt(0)" ::: "memory"); __syncthreads();
            float den = 0.f;
#pragma unroll
            for (int r = 0; r < 16; ++r) { const int s0 = nsa::crow(r, hi);
                p0[r] = (s0 <= tl) ? p0[r] * __builtin_amdgcn_exp2f(et + gL[h * 64 + s0]) : 0.f; p1[r] = (s0 + 32 <= tl) ? p1[r] * __builtin_amdgcn_exp2f(et + gL[h * 64 + s0 + 32]) : 0.f; den += p0[r] + p1[r]; }
            float qn = 0.f;
#pragma unroll
            for (int d0 = 0; d0 < 4; ++d0)
#pragma unroll
                for (int j = 0; j < 8; ++j) qn += bf2f((unsigned short)qf[d0][j]) * nL[h * 64 + 16 * d0 + 8 * hi + j];
            den = nsa::swapsum(den) + av * nsa::swapsum(qn);
            nsa::f32x16 acc[4]; acc[0] = (nsa::f32x16){}; acc[1] = (nsa::f32x16){}; acc[2] = (nsa::f32x16){}; acc[3] = (nsa::f32x16){};
            const nsa::lds_cptr cb = (nsa::lds_cptr)lds + 65536 + h * 16384 + loff, vb = (nsa::lds_cptr)lds + h * 16384 + loff;
#pragma unroll
            for (int ks = 0; ks < 4; ++ks)
#pragma unroll
                for (int vt = 0; vt < 4; ++vt) { const nsa::s16x4 lo = nsa::vtr(cb + vt * 4096 + ks * 1024), hh_ = nsa::vtr(cb + vt * 4096 + ks * 1024 + 512);
                    const nsa::bf16x8 cf = (nsa::bf16x8){lo[0], lo[1], lo[2], lo[3], hh_[0], hh_[1], hh_[2], hh_[3]};
                    acc[vt] = __builtin_amdgcn_mfma_f32_32x32x16_bf16(cf, qf[ks], acc[vt], 0, 0, 0); }
#pragma unroll
            for (int vt = 0; vt < 4; ++vt)
#pragma unroll
                for (int r = 0; r < 16; ++r) acc[vt][r] *= av;
            nsa::u32x4 pw[4];
            pw[0] = (nsa::u32x4){nsa::cvtpk(p0[0], p0[1]), nsa::cvtpk(p0[2], p0[3]), nsa::cvtpk(p0[4], p0[5]), nsa::cvtpk(p0[6], p0[7])}; pw[1] = (nsa::u32x4){nsa::cvtpk(p0[8], p0[9]), nsa::cvtpk(p0[10], p0[11]), nsa::cvtpk(p0[12], p0[13]), nsa::cvtpk(p0[14], p0[15])};
            pw[2] = (nsa::u32x4){nsa::cvtpk(p1[0], p1[1]), nsa::cvtpk(p1[2], p1[3]), nsa::cvtpk(p1[4], p1[5]), nsa::cvtpk(p1[6], p1[7])}; pw[3] = (nsa::u32x4){nsa::cvtpk(p1[8], p1[9]), nsa::cvtpk(p1[10], p1[11]), nsa::cvtpk(p1[12], p1[13]), nsa::cvtpk(p1[14], p1[15])};
#pragma unroll
            for (int ks = 0; ks < 4; ++ks)
#pragma unroll
                for (int vt = 0; vt < 4; ++vt) { const nsa::s16x4 lo = nsa::vtr(vb + vt * 4096 + ks * 1024), hh_ = nsa::vtr(vb + vt * 4096 + ks * 1024 + 512);
                    const nsa::bf16x8 vf = (nsa::bf16x8){lo[0], lo[1], lo[2], lo[3], hh_[0], hh_[1], hh_[2], hh_[3]};
                    acc[vt] = __builtin_amdgcn_mfma_f32_32x32x16_bf16(vf, __builtin_bit_cast(nsa::bf16x8, pw[ks]), acc[vt], 0, 0, 0); }
            const float inv = 1.0f / fmaxf(fabsf(den), __expf(-mt)); float ss = 0.f;
#pragma unroll
            for (int vt = 0; vt < 4; ++vt)
#pragma unroll
                for (int r = 0; r < 16; ++r) { acc[vt][r] *= inv; ss += acc[vt][r] * acc[vt][r]; }
            const float rstd = 1.0f / sqrtf(nsa::swapsum(ss) * (1.0f / 128.0f) + EPS);
            const bf16* mo = PROJ + trow * NPROJ_PAD + C_MO + 128 * h; bf16* yo = YMIX + trow * D + 512 + 128 * h;
#pragma unroll
            for (int vt = 0; vt < 4; ++vt)
#pragma unroll
                for (int a4 = 0; a4 < 4; ++a4) { const int v0 = 32 * vt + 8 * a4 + 4 * hi; const nsa::u32x2 mw = *(const nsa::u32x2*)(mo + v0); const LAS float* gp = gnL + 128 * h + v0;
                    const float y0 = sigmoid_f(bflo(mw.x)) * (acc[vt][4 * a4] * rstd * gp[0]), y1 = sigmoid_f(bfhi(mw.x)) * (acc[vt][4 * a4 + 1] * rstd * gp[1]);
                    const float y2 = sigmoid_f(bflo(mw.y)) * (acc[vt][4 * a4 + 2] * rstd * gp[2]), y3 = sigmoid_f(bfhi(mw.y)) * (acc[vt][4 * a4 + 3] * rstd * gp[3]);
                    nsa::u32x2 w; w.x = nsa::cvtpk(y0, y1); w.y = nsa::cvtpk(y2, y3); *(nsa::u32x2*)(yo + v0) = w; }
            __syncthreads();
        }
    }
    SEAM(6);

    if (IN(7)) { pg8::Gemm g{YMIX, Wout_t, D, D, D}; pg8::GridOrder S; S.init(T, D, D, D, G, bx); pg8::EpiF32 E{Y1, D};
        pg8::gemm_phase<pg8::EpiF32, pg8::GridOrder, true, true>(lds, g, S, E); }
    SEAM(7);
    if (IN(8)) { for (int m = gw; m < T; m += NGW) resnorm_row(Y1 + (size_t)m * D, x_in + (size_t)m * D, g_mix_post, out_p + (size_t)m * D, g_x_pre, H + (size_t)m * D, lane); }
    SEAM(8);
    if (IN(9)) { pg8::Gemm g{H, Wxq_t, D, D, D}; pg8::GridOrder S; S.init(T, D, D, D, G, bx); pg8::EpiBf16 E{QX, D, 0.0625f, 1.0f, 0};
        pg8::gemm_phase<pg8::EpiBf16, pg8::GridOrder, true, true>(lds, g, S, E); }
    SEAM(9);
    if (IN(10)) { pg8::Gemm g{QX, MEMK, D, D, 256}; XaSOrder S{G, bx}; pg8::EpiF32 E{Y1, D};
        pg8::gemm_phase<pg8::EpiF32, XaSOrder, true, true>(lds, g, S, E); }
    SEAM(10);
    if (IN(11)) {
        for (int m = gw; m < T; m += NGW) {
            const GAS f32x4* sr = (const GAS f32x4*)(Y1 + (size_t)m * D) + lane; GAS unsigned long long* o8 = (GAS unsigned long long*)(PB + (size_t)m * D) + lane;
#pragma unroll
            for (int h = 0; h < 4; ++h) { const f32x4 v = sr[64 * h]; const float mx = wave_max(fmaxf(fmaxf(v.x, v.y), fmaxf(v.z, v.w)));
                f32x4 p; p.x = __expf(v.x - mx); p.y = __expf(v.y - mx); p.z = __expf(v.z - mx); p.w = __expf(v.w - mx);
                const float inv = 1.0f / wave_sum((p.x + p.y) + (p.z + p.w));
                o8[64 * h] = (unsigned long long)pk2(p.x * inv, p.y * inv) | ((unsigned long long)pk2(p.z * inv, p.w * inv) << 32); }
        }
    }
    SEAM(11);
    if (IN(12)) { pg8::Gemm g{PB, VT, D, BATCH * MEMT, 256}; XaPVOrder S{G, bx}; pg8::EpiBf16 E{OX, D, 1.0f, 1.0f, 0};
        pg8::gemm_phase<pg8::EpiBf16, XaPVOrder, true, true>(lds, g, S, E); }
    SEAM(12);
    if (IN(13)) { pg8::Gemm g{OX, Wxo_t, D, D, D}; pg8::GridOrder S; S.init(T, D, D, D, G, bx); pg8::EpiF32 E{Y1, D};
        pg8::gemm_phase<pg8::EpiF32, pg8::GridOrder, true, true>(lds, g, S, E); }
    SEAM(13);
    if (IN(14)) { for (int m = gw; m < T; m += NGW) resnorm_row(Y1 + (size_t)m * D, out_p + (size_t)m * D, g_x_post, out_p + (size_t)m * D, g_ffn_pre, H + (size_t)m * D, lane); }
    SEAM(14);
    if (IN(15)) { pg8::Gemm g{H, Wgu_t, D, D, D}; pg8::GridOrder S; S.init(T, 2 * DFF, D, D, G, bx); pg8::EpiSwiglu E{ACT, DFF};
        pg8::gemm_phase<pg8::EpiSwiglu, pg8::GridOrder, true, true>(lds, g, S, E); }
    SEAM(15);
    if (IN(16)) { pg8::Gemm g{ACT, Wdn_t, DFF, DFF, DFF}; pg8::GridOrder S; S.init(T, D, DFF, DFF, G, bx); pg8::EpiF32 E{Y2, D};
        pg8::gemm_phase<pg8::EpiF32, pg8::GridOrder, true, true>(lds, g, S, E); }
    SEAM(16);
    if (IN(17)) { for (int m = gw; m < T; m += NGW) resnorm_row(Y2 + (size_t)m * D, out_p + (size_t)m * D, g_ffn_post, out_p + (size_t)m * D, nullptr, nullptr, lane); }
#undef IN
#undef SEAM
}

extern "C" void kernel_launch(void* const* d_in, const int* in_sizes, int n_in, void* d_out, int out_size, void* d_ws, size_t ws_size, hipStream_t stream) {
    static int grid = 0;
    if (grid == 0) {
        if (n_in != 27 || in_sizes[0] != T * D || out_size != T * D || ws_size < WS_END) { fprintf(stderr, "kernel_launch: unexpected shapes (n_in %d, in0 %d, out %d, ws %zu); nothing launched\n", n_in, n_in > 0 ? in_sizes[0] : -1, out_size, ws_size); grid = -1; return; }
        int dev = 0, cus = 0, per_cu = 0;
        if (hipGetDevice(&dev) != hipSuccess || hipDeviceGetAttribute(&cus, hipDeviceAttributeMultiprocessorCount, dev) != hipSuccess) { grid = -1; return; }
        if (hipFuncSetAttribute((const void*)hymba_fwd, hipFuncAttributeMaxDynamicSharedMemorySize, LDS_BYTES) != hipSuccess) { fprintf(stderr, "kernel_launch: hipFuncSetAttribute failed\n"); grid = -1; return; }
        if (hipOccupancyMaxActiveBlocksPerMultiprocessor(&per_cu, (const void*)hymba_fwd, NWAVES * 64, LDS_BYTES) != hipSuccess || per_cu < 1) fprintf(stderr, "kernel_launch: occupancy query reports %d workgroups per CU\n", per_cu);
        (void)hipGetLastError();
        grid = cus;
    }
    if (grid < 0) return;
    if (hipMemsetAsync((char*)d_ws + WS_CTL, 0, CTL_ZERO_BYTES, stream) != hipSuccess) return;
    Args a{};
    for (int i = 0; i < 27; ++i) a.in[i] = (const float*)d_in[i];
    a.out = (float*)d_out; a.ws = (unsigned char*)d_ws;
#if MK_ONE_LAUNCH
    a.ph_lo = 0; a.ph_hi = NPHASE;
    hipLaunchKernelGGL(hymba_fwd, dim3(grid), dim3(NWAVES * 64), LDS_BYTES, stream, a);
#else
    for (int p = 0; p < NPHASE; ++p) { a.ph_lo = p; a.ph_hi = p + 1; hipLaunchKernelGGL(hymba_fwd, dim3(grid), dim3(NWAVES * 64), LDS_BYTES, stream, a); }
#endif
}
```
